# Optimizing an MI355X kernel written in HIP

```python
import jax, jax.numpy as jnp
from jax import lax
import numpy as np

D_MODEL = 2048
BATCH = 1
SEQ = 8192
DEPTH = 2
DEC_BATCH = 8
DEC_SEQ = 64
PAST_LEN = 1024

CHUNK = 64
D_CONV = D_MODEL // 2
SC_WIDTH = 3
SSD_HEAD_DIM = 64
D_INNER = D_MODEL
SSD_HEADS = D_INNER // SSD_HEAD_DIM
SSD_GROUPS = 8
SSD_STATE = 128
SSD_CONV_WIDTH = 4
D_XBC = D_INNER + 2 * SSD_GROUPS * SSD_STATE
D_MIX = D_CONV + D_INNER
D_IN_PROJ = 3 * D_CONV + D_INNER + D_XBC + SSD_HEADS
D_FF = 11 * D_MODEL // 4
EPS = 1e-6

kernel_name = "hymba_shortconv_ssd_macaron_stream_step"


def rmsnorm(x, g):
    xf = x.astype(jnp.float32)
    y = xf * lax.rsqrt(jnp.mean(xf * xf, axis=-1, keepdims=True) + EPS)
    return (y * g.astype(jnp.float32)).astype(x.dtype)


def swiglu(h, w_gate, w_up, w_down):
    return (jax.nn.silu(h @ w_gate) * (h @ w_up)) @ w_down


def causal_dwconv(u, hist, w, bias=None):
    width = w.shape[0]
    T = u.shape[1]
    full = jnp.concatenate([hist.astype(u.dtype), u], axis=1)
    y = full[:, 0:T] * w[0]
    for k in range(1, width):
        y = y + full[:, k:k + T] * w[k]
    if bias is not None:
        y = y + bias
    return y, full[:, T:]


def ssd_scan(x, dt, A, Bm, Cm, init_state):
    b, T, H, P = x.shape
    G, N = Bm.shape[2], Bm.shape[3]
    R = H // G
    Q = min(CHUNK, T)
    nc = T // Q
    f32 = jnp.float32
    xs = (x.astype(f32) * dt[..., None]).reshape(b, nc, Q, G, R, P)
    dA = (dt * A).reshape(b, nc, Q, G, R)
    Bc = Bm.astype(f32).reshape(b, nc, Q, G, N)
    Cc = Cm.astype(f32).reshape(b, nc, Q, G, N)
    Acum = jnp.cumsum(dA, axis=2)
    seg = Acum[:, :, :, None] - Acum[:, :, None, :]
    mask = jnp.tril(jnp.ones((Q, Q), dtype=bool))[:, :, None, None]
    Lmat = jnp.exp(jnp.where(mask, seg, -jnp.inf))
    CB = jnp.einsum("bclgn,bcsgn->bclsg", Cc, Bc)
    y_diag = jnp.einsum("bclsgr,bcsgrp->bclgrp", CB[..., None] * Lmat, xs)
    decay_to_end = jnp.exp(Acum[:, :, -1:] - Acum)
    blk_states = jnp.einsum("bclgn,bclgrp->bcgrpn", Bc, xs * decay_to_end[..., None])
    blk_decay = jnp.exp(Acum[:, :, -1])

    def step(s, inp):
        dec, add = inp
        return s * dec[..., None, None] + add, s

    s0 = init_state.astype(f32).reshape(b, G, R, P, N)
    final, prev = lax.scan(step, s0, (jnp.moveaxis(blk_decay, 1, 0), jnp.moveaxis(blk_states, 1, 0)))
    prev = jnp.moveaxis(prev, 0, 1)
    y_off = jnp.einsum("bclgn,bcgrpn->bclgrp", Cc, prev) * jnp.exp(Acum)[..., None]
    y = (y_diag + y_off).reshape(b, T, H, P)
    return y, final.reshape(b, H, P, N).astype(init_state.dtype)


def gated_group_rmsnorm(y, z, w):
    b, T, _ = y.shape
    u = y.astype(jnp.float32) * jax.nn.silu(z.astype(jnp.float32))
    u = u.reshape(b, T, SSD_GROUPS, D_INNER // SSD_GROUPS)
    u = u * lax.rsqrt(jnp.mean(u * u, axis=-1, keepdims=True) + EPS)
    return (u.reshape(b, T, D_INNER) * w.astype(jnp.float32)).astype(y.dtype)


def hybrid_mixer(h, sc_hist, xbc_hist, ssm_state, p, l):
    b, T, _ = h.shape
    proj = h @ p["w_in_mix"][l]
    splits = [D_CONV, 2 * D_CONV, 3 * D_CONV, 3 * D_CONV + D_INNER, 3 * D_CONV + D_INNER + D_XBC]
    sc_b, sc_c, sc_x, z, xbc, dt_raw = jnp.split(proj, splits, axis=-1)
    conv_a, new_sc = causal_dwconv(sc_c * sc_x, sc_hist, p["sc_conv_w"][l])
    y_a = sc_b * conv_a
    xbc_c, new_xbc = causal_dwconv(xbc, xbc_hist, p["ssd_conv_w"][l], p["ssd_conv_b"][l])
    xbc_c = jax.nn.silu(xbc_c)
    xs, Bm, Cm = jnp.split(xbc_c, [D_INNER, D_INNER + SSD_GROUPS * SSD_STATE], axis=-1)
    xs = xs.reshape(b, T, SSD_HEADS, SSD_HEAD_DIM)
    Bm = Bm.reshape(b, T, SSD_GROUPS, SSD_STATE)
    Cm = Cm.reshape(b, T, SSD_GROUPS, SSD_STATE)
    dt = jax.nn.softplus(dt_raw.astype(jnp.float32) + p["ssd_dt_bias"][l].astype(jnp.float32))
    A = -jnp.exp(p["ssd_A_log"][l].astype(jnp.float32))
    y, new_ssm = ssd_scan(xs, dt, A, Bm, Cm, ssm_state)
    y = y + xs.astype(jnp.float32) * p["ssd_D"][l].astype(jnp.float32)[:, None]
    y_b = gated_group_rmsnorm(y.reshape(b, T, D_INNER).astype(h.dtype), z, p["ssd_norm"][l])
    out = jnp.concatenate([y_a, y_b], axis=-1) @ p["w_out_mix"][l]
    return out, new_sc, new_xbc, new_ssm


def run_trunk(x, sc_hist, xbc_hist, ssm, p):
    new_sc, new_xbc, new_ssm = [], [], []
    for l in range(DEPTH):
        h = rmsnorm(x, p["ffn1_norm"][l])
        x = x + 0.5 * swiglu(h, p["ffn1_w_gate"][l], p["ffn1_w_up"][l], p["ffn1_w_down"][l])
        mix, s_sc, s_xbc, s_ssm = hybrid_mixer(rmsnorm(x, p["mix_norm"][l]), sc_hist[l], xbc_hist[l], ssm[l], p, l)
        x = x + mix
        h = rmsnorm(x, p["ffn2_norm"][l])
        x = x + 0.5 * swiglu(h, p["ffn2_w_gate"][l], p["ffn2_w_up"][l], p["ffn2_w_down"][l])
        new_sc.append(s_sc)
        new_xbc.append(s_xbc)
        new_ssm.append(s_ssm)
    return rmsnorm(x, p["final_norm"]), jnp.stack(new_sc), jnp.stack(new_xbc), jnp.stack(new_ssm)


def setup_inputs(seed: int = 0) -> dict:
    key = jax.random.key(seed)
    ks = jax.random.split(key, 24)
    f32 = jnp.float32
    nrm = lambda k, shape, s: jax.random.normal(k, shape, f32) * s
    dt0 = jnp.exp(jax.random.uniform(ks[10], (DEPTH, SSD_HEADS), f32) * (jnp.log(0.1) - jnp.log(0.001)) + jnp.log(0.001))
    return {
        "x_prompt": nrm(ks[0], (BATCH, SEQ, D_MODEL), 1.0),
        "x_sample": nrm(ks[1], (DEC_BATCH, DEC_SEQ, D_MODEL), 1.0),
        "state_sc_conv": nrm(ks[2], (DEPTH, DEC_BATCH, SC_WIDTH - 1, D_CONV), 1.0),
        "state_ssd_conv": nrm(ks[3], (DEPTH, DEC_BATCH, SSD_CONV_WIDTH - 1, D_XBC), 1.0),
        "state_ssm": nrm(ks[4], (DEPTH, DEC_BATCH, SSD_HEADS, SSD_HEAD_DIM, SSD_STATE), 0.5),
        "ffn1_norm": 1.0 + nrm(ks[5], (DEPTH, D_MODEL), 0.02),
        "ffn1_w_gate": nrm(ks[6], (DEPTH, D_MODEL, D_FF), D_MODEL ** -0.5),
        "ffn1_w_up": nrm(ks[7], (DEPTH, D_MODEL, D_FF), D_MODEL ** -0.5),
        "ffn1_w_down": nrm(ks[8], (DEPTH, D_FF, D_MODEL), D_FF ** -0.5),
        "mix_norm": 1.0 + nrm(ks[9], (DEPTH, D_MODEL), 0.02),
        "w_in_mix": nrm(ks[11], (DEPTH, D_MODEL, D_IN_PROJ), D_MODEL ** -0.5),
        "sc_conv_w": nrm(ks[12], (DEPTH, SC_WIDTH, D_CONV), SC_WIDTH ** -0.5),
        "ssd_conv_w": nrm(ks[13], (DEPTH, SSD_CONV_WIDTH, D_XBC), SSD_CONV_WIDTH ** -0.5),
        "ssd_conv_b": nrm(ks[14], (DEPTH, D_XBC), 0.02),
        "ssd_dt_bias": dt0 + jnp.log(-jnp.expm1(-dt0)),
        "ssd_A_log": jnp.log(jax.random.uniform(ks[15], (DEPTH, SSD_HEADS), f32, 1.0, 16.0)),
        "ssd_D": 1.0 + nrm(ks[16], (DEPTH, SSD_HEADS), 0.02),
        "ssd_norm": 1.0 + nrm(ks[17], (DEPTH, D_INNER), 0.02),
        "w_out_mix": nrm(ks[18], (DEPTH, D_MIX, D_MODEL), D_MIX ** -0.5),
        "ffn2_norm": 1.0 + nrm(ks[19], (DEPTH, D_MODEL), 0.02),
        "ffn2_w_gate": nrm(ks[20], (DEPTH, D_MODEL, D_FF), D_MODEL ** -0.5),
        "ffn2_w_up": nrm(ks[21], (DEPTH, D_MODEL, D_FF), D_MODEL ** -0.5),
        "ffn2_w_down": nrm(ks[22], (DEPTH, D_FF, D_MODEL), D_FF ** -0.5),
        "final_norm": 1.0 + nrm(ks[23], (D_MODEL,), 0.02),
    }


def reference(x_prompt, x_sample, state_sc_conv, state_ssd_conv, state_ssm,
              ffn1_norm, ffn1_w_gate, ffn1_w_up, ffn1_w_down, mix_norm, w_in_mix,
              sc_conv_w, ssd_conv_w, ssd_conv_b, ssd_dt_bias, ssd_A_log, ssd_D, ssd_norm,
              w_out_mix, ffn2_norm, ffn2_w_gate, ffn2_w_up, ffn2_w_down, final_norm):
    p = dict(ffn1_norm=ffn1_norm, ffn1_w_gate=ffn1_w_gate, ffn1_w_up=ffn1_w_up, ffn1_w_down=ffn1_w_down,
             mix_norm=mix_norm, w_in_mix=w_in_mix, sc_conv_w=sc_conv_w, ssd_conv_w=ssd_conv_w,
             ssd_conv_b=ssd_conv_b, ssd_dt_bias=ssd_dt_bias, ssd_A_log=ssd_A_log, ssd_D=ssd_D,
             ssd_norm=ssd_norm, w_out_mix=w_out_mix, ffn2_norm=ffn2_norm, ffn2_w_gate=ffn2_w_gate,
             ffn2_w_up=ffn2_w_up, ffn2_w_down=ffn2_w_down, final_norm=final_norm)
    b0 = x_prompt.shape[0]
    dt_ = x_prompt.dtype
    zero_sc = jnp.zeros((DEPTH, b0, SC_WIDTH - 1, D_CONV), dt_)
    zero_xbc = jnp.zeros((DEPTH, b0, SSD_CONV_WIDTH - 1, D_XBC), dt_)
    zero_ssm = jnp.zeros((DEPTH, b0, SSD_HEADS, SSD_HEAD_DIM, SSD_STATE), dt_)
    y_prompt, p_sc, p_xbc, p_ssm = run_trunk(x_prompt, zero_sc, zero_xbc, zero_ssm, p)
    y_sample, s_sc, s_xbc, s_ssm = run_trunk(x_sample, state_sc_conv, state_ssd_conv, state_ssm, p)
    return (y_prompt, y_sample, p_sc, p_xbc, p_ssm, s_sc, s_xbc, s_ssm)
```

```cpp
#include <hip/hip_runtime.h>
#include <hip/hip_cooperative_groups.h>
#include <cstdio>
namespace cg = cooperative_groups;

#ifndef ONE_LAUNCH
#define ONE_LAUNCH 1
#endif

#define LAS __attribute__((address_space(3)))
typedef unsigned short bf16_t;
typedef short bf16x8 __attribute__((ext_vector_type(8)));
typedef float f32x4 __attribute__((ext_vector_type(4)));
typedef float f32x2 __attribute__((ext_vector_type(2)));
typedef unsigned u32x4 __attribute__((ext_vector_type(4)));
typedef unsigned u32x2 __attribute__((ext_vector_type(2)));

constexpr int D_MODEL = 2048, M_ROWS = 8704, NCHUNK = 136, NPCH = 128;
constexpr int D_FF = 5632, PROJ_LD = 9216, N_IN = 9248, N_IN_PAD = 9472, D_MIX = 3072;
constexpr float EPS = 1e-6f;
constexpr int NTHREADS = 512;
constexpr int LDS_BYTES = 131072;

constexpr size_t O_SC_P = 17825792, O_CONV_P = 17829888, O_SSM_P = 17854464, O_SC_S = 18378752, O_CONV_S = 18411520, O_SSM_S = 18608128;

constexpr size_t SZ_WGU = (size_t)11264 * 2048 * 2, SZ_WD = (size_t)2048 * 5632 * 2, SZ_WIN = (size_t)N_IN_PAD * 2048 * 2, SZ_WOUT = (size_t)2048 * 3072 * 2;
constexpr size_t OFF_WGU1 = 0, OFF_WD1 = SZ_WGU, OFF_WIN = SZ_WGU + SZ_WD, OFF_WOUT = OFF_WIN + SZ_WIN, OFF_WGU2 = OFF_WOUT + SZ_WOUT, OFF_WD2 = OFF_WGU2 + SZ_WGU;
constexpr size_t SZ_LAYERW = 2 * SZ_WGU + 2 * SZ_WD + SZ_WIN + SZ_WOUT;
constexpr size_t WS_X = 2 * SZ_LAYERW;
constexpr size_t WS_H = WS_X + (size_t)M_ROWS * 2048 * 4;
constexpr size_t WS_PROJ = WS_H + (size_t)M_ROWS * 2048 * 2;
constexpr size_t WS_MIX = WS_PROJ + (size_t)M_ROWS * PROJ_LD * 2;
constexpr size_t WS_ST = WS_MIX + (size_t)M_ROWS * D_MIX * 2;
constexpr size_t WS_DT = WS_ST + (size_t)NCHUNK * 32 * 64 * 128 * 2;
constexpr size_t WS_DEC = WS_DT + (size_t)M_ROWS * 32 * 4;
constexpr size_t WS_END = WS_DEC + (size_t)NCHUNK * 32 * 4;

struct Params { const float* in[24]; float* out; unsigned char* ws; int ph_lo, ph_hi; };

__device__ __forceinline__ float bf_lo(unsigned u) { return __uint_as_float(u << 16); }
__device__ __forceinline__ float bf_hi(unsigned u) { return __uint_as_float(u & 0xffff0000u); }
typedef __bf16 bf16x2v __attribute__((ext_vector_type(2)));
__device__ __forceinline__ unsigned cvt_pk_bf16(float lo, float hi) { f32x2 v = {lo, hi}; bf16x2v b = __builtin_convertvector(v, bf16x2v); return __builtin_bit_cast(unsigned, b); }
__device__ __forceinline__ float silu_f(float x) { return x / (1.f + __expf(-x)); }
__device__ __forceinline__ float softplus_f(float x) { return x > 20.f ? x : log1pf(expf(x)); }
__device__ __forceinline__ int opaque_tid() { int t = threadIdx.x; asm volatile("" : "+v"(t)); return t; }
__device__ __forceinline__ float bfv(const u32x4& v, int j) { const unsigned w = v[j >> 1]; return (j & 1) ? bf_hi(w) : bf_lo(w); }

namespace pg8 {
constexpr int BM = 256, BK = 64, HALF = 128, HTB = HALF * BK * 2, STAGE_BYTES = 8 * HTB, NXCD = 8, WGM = 8;
__host__ __device__ __forceinline__ int lds_byte(int r, int c) { const int st = (r >> 4) * 2 + (c >> 5), rr = r & 15, cc = c & 31, ob = rr * 64 + cc * 2; return st * 1024 + (ob ^ (((ob >> 9) & 1) << 5)); }
__host__ __device__ __forceinline__ void stage_rc(int b, int& R, int& C) { const int st = b / 1024, sb = b % 1024, swz = sb ^ (((sb >> 9) & 1) << 5); R = (st >> 1) * 16 + swz / 64; C = (st & 1) * 32 + (swz % 64) / 2; }
__host__ __device__ __forceinline__ int perm32(int rho) { const int n = rho >> 4, i = rho & 15; return 8 * (i >> 2) + 4 * n + (i & 3); }

struct Unit { int pm, pn, kofs; };
struct Gemm { const bf16_t* A; const bf16_t* Bt; int M, N, ld, Kc; };

template <int M, int N, int KS, int Kc>
struct SplitOrder {
    static constexpr int nM = M / BM, nN = N / BM, nwg = nM * nN;
    int G, c;
    __device__ void init(int G_, int c_) { G = G_; c = c_; }
    __device__ bool next(int i, Unit& u) const {
        const int L = i * G + c; if (L >= nwg * KS) return false;
        const int ks = L / nwg; int wgid = L - ks * nwg;
        { const int q = nwg / NXCD, r = nwg % NXCD, xcd = wgid % NXCD, off = wgid / NXCD; wgid = (xcd < r ? xcd * (q + 1) : r * (q + 1) + (xcd - r) * q) + off; }
        const int nig = WGM * nN, gid = wgid / nig, fm = gid * WGM, gsz = (nM - fm) < WGM ? (nM - fm) : WGM;
        u.pm = fm + ((wgid % nig) % gsz); u.pn = (wgid % nig) / gsz; u.kofs = ks * Kc; return true;
    }
};

struct EpiSwiglu {
    static constexpr bool PERM = true;
    bf16_t* O;
    __device__ __forceinline__ void operator()(const f32x4 (&acc)[2][2][4][2], const Unit& u, int wr, int wc, int fr, int fq) const {
        const int row0 = u.pm * BM + wr * 64 + fr, col0 = u.pn * 128 + wc * 32 + 8 * fq;
#pragma unroll
        for (int ai = 0; ai < 2; ++ai)
#pragma unroll
            for (int m = 0; m < 4; ++m) {
                bf16_t* rowp = O + (size_t)(row0 + ai * HALF + m * 16) * D_FF + col0;
                const f32x4 g0 = acc[ai][0][m][0], g1 = acc[ai][0][m][1], u0 = acc[ai][1][m][0], u1 = acc[ai][1][m][1];
                u32x4 w;
                w.x = cvt_pk_bf16(silu_f(g0[0]) * u0[0], silu_f(g0[1]) * u0[1]); w.y = cvt_pk_bf16(silu_f(g0[2]) * u0[2], silu_f(g0[3]) * u0[3]);
                w.z = cvt_pk_bf16(silu_f(g1[0]) * u1[0], silu_f(g1[1]) * u1[1]); w.w = cvt_pk_bf16(silu_f(g1[2]) * u1[2], silu_f(g1[3]) * u1[3]);
                *(u32x4*)rowp = w;
            }
    }
};
struct EpiAtomic {
    static constexpr bool PERM = false;
    float* X; float scale;
    __device__ __forceinline__ void operator()(const f32x4 (&acc)[2][2][4][2], const Unit& u, int wr, int wc, int fr, int fq) const {
        const int row0 = u.pm * BM + wr * 64 + fr, col0 = u.pn * BM + wc * 32 + 4 * fq;
#pragma unroll
        for (int ai = 0; ai < 2; ++ai)
#pragma unroll
            for (int m = 0; m < 4; ++m) {
                float* rowp = X + (size_t)(row0 + ai * HALF + m * 16) * D_MODEL + col0;
                f32x4 xv[2][2];
#pragma unroll
                for (int bj = 0; bj < 2; ++bj)
#pragma unroll
                    for (int n = 0; n < 2; ++n) xv[bj][n] = *(const f32x4*)(rowp + bj * HALF + n * 16);
#pragma unroll
                for (int bj = 0; bj < 2; ++bj)
#pragma unroll
                    for (int n = 0; n < 2; ++n) *(f32x4*)(rowp + bj * HALF + n * 16) = xv[bj][n] + scale * acc[ai][bj][m][n];
            }
    }
};
struct EpiProj {
    static constexpr bool PERM = true;
    bf16_t* P; float* DT;
    __device__ __forceinline__ void operator()(const f32x4 (&acc)[2][2][4][2], const Unit& u, int wr, int wc, int fr, int fq) const {
        const int row0 = u.pm * BM + wr * 64 + fr;
        if (u.pn < 36) {
            const int col0 = u.pn * BM + wc * 32 + 8 * fq;
#pragma unroll
            for (int ai = 0; ai < 2; ++ai)
#pragma unroll
                for (int m = 0; m < 4; ++m) {
                    bf16_t* rowp = P + (size_t)(row0 + ai * HALF + m * 16) * PROJ_LD + col0;
#pragma unroll
                    for (int bj = 0; bj < 2; ++bj) {
                        const f32x4 v0 = acc[ai][bj][m][0], v1 = acc[ai][bj][m][1];
                        u32x4 w; w.x = cvt_pk_bf16(v0[0], v0[1]); w.y = cvt_pk_bf16(v0[2], v0[3]); w.z = cvt_pk_bf16(v1[0], v1[1]); w.w = cvt_pk_bf16(v1[2], v1[3]);
                        *(u32x4*)(rowp + bj * HALF) = w;
                    }
                }
        } else if (wc == 0) {
#pragma unroll
            for (int ai = 0; ai < 2; ++ai)
#pragma unroll
                for (int m = 0; m < 4; ++m) {
                    float* rowp = DT + (size_t)(row0 + ai * HALF + m * 16) * 32 + 8 * fq;
                    *(f32x4*)rowp = acc[ai][0][m][0]; *(f32x4*)(rowp + 4) = acc[ai][0][m][1];
                }
        }
    }
};

template <class Epi, class Sched, int LD, int KC>
__device__ __forceinline__ void gemm_phase(LAS unsigned char* lds, const Gemm g, const Sched& S, const Epi& E) {
    const int tid = opaque_tid(), wid = __builtin_amdgcn_readfirstlane(tid >> 6), lane = tid & 63, wr = wid >> 2, wc = wid & 3, fr = lane & 15, fq = lane >> 4;
    constexpr int K = LD, nt = KC / BK;
    unsigned voffA[2], voffB[2];
#pragma unroll
    for (int i = 0; i < 2; ++i) { int R, C; stage_rc(tid * 16 + i * 8192, R, C); const int Rb = Epi::PERM ? ((R & ~31) + perm32(R & 31)) : R;
        voffA[i] = (unsigned)(R * K + C) * 2u; voffB[i] = (unsigned)(Rb * K + C) * 2u; }
    const size_t kstep = (size_t)(BK * 2);
    const size_t hstep = (size_t)HALF * K * 2;
    const size_t tstep = 2 * hstep;
    const unsigned ldsw = (unsigned)wid * 1024u;
    const int aoff = lds_byte(wr * 64 + fr, fq * 8), boff = lds_byte(wc * 32 + fr, fq * 8);
#define PG8_SA(b, h) (((b) * 2 + (h)) * HTB)
#define PG8_SB(b, h) ((4 + (b) * 2 + (h)) * HTB)
#define PG8_STAGE(bufoff, gbase, voff) do { _Pragma("unroll") for (int _i = 0; _i < 2; ++_i) \
        __builtin_amdgcn_global_load_lds((const unsigned*)((const char*)(gbase) + (voff)[_i]), (LAS unsigned*)(lds + (bufoff) + ldsw + _i * 8192), 16, 0, 0); } while (0)
#define PG8_LDA(dst, b, h) do { _Pragma("unroll") for (int m = 0; m < 4; ++m) _Pragma("unroll") for (int k = 0; k < 2; ++k) dst[m][k] = *(const LAS bf16x8*)(lds + PG8_SA(b, h) + aoff + m * 2048 + k * 1024); } while (0)
#define PG8_LDB(dst, b, h) do { _Pragma("unroll") for (int n = 0; n < 2; ++n) _Pragma("unroll") for (int k = 0; k < 2; ++k) dst[n][k] = *(const LAS bf16x8*)(lds + PG8_SB(b, h) + boff + n * 2048 + k * 1024); } while (0)
#define PG8_MMA(ai, bj, At, Bt) do { __builtin_amdgcn_s_setprio(1); _Pragma("unroll") for (int m = 0; m < 4; ++m) _Pragma("unroll") for (int n = 0; n < 2; ++n) _Pragma("unroll") for (int k = 0; k < 2; ++k) \
        acc[ai][bj][m][n] = __builtin_amdgcn_mfma_f32_16x16x32_bf16(Bt[n][k], At[m][k], acc[ai][bj][m][n], 0, 0, 0); __builtin_amdgcn_s_setprio(0); } while (0)
#define PG8_WAIT_V(n) asm volatile("s_waitcnt vmcnt(" #n ")" ::: "memory")
#define PG8_WAIT_L(n) asm volatile("s_waitcnt lgkmcnt(" #n ")" ::: "memory")
#define PG8_BAR __builtin_amdgcn_s_barrier()
#define PG8_SCHED __builtin_amdgcn_sched_barrier(0)
    Unit cur, nxt; int ui = 0;
    if (!S.next(0, cur)) return;
    f32x4 acc[2][2][4][2];
#pragma unroll
    for (int a = 0; a < 2; ++a)
#pragma unroll
        for (int b = 0; b < 2; ++b)
#pragma unroll
            for (int m = 0; m < 4; ++m)
#pragma unroll
                for (int n = 0; n < 2; ++n) acc[a][b][m][n] = (f32x4){0.f, 0.f, 0.f, 0.f};
    bf16x8 At[4][2], B0[2][2], B1[2][2];
    const char* cA = (const char*)g.A + (size_t)cur.pm * tstep + (size_t)cur.kofs * 2; const char* cB = (const char*)g.Bt + (size_t)cur.pn * tstep + (size_t)cur.kofs * 2;
    PG8_STAGE(PG8_SB(0, 0), cB, voffB); PG8_STAGE(PG8_SA(0, 0), cA, voffA); PG8_STAGE(PG8_SB(0, 1), cB + hstep, voffB); PG8_STAGE(PG8_SA(0, 1), cA + hstep, voffA);
    if (wr == 1) PG8_BAR;
    PG8_WAIT_V(4); PG8_BAR;
    PG8_STAGE(PG8_SB(1, 0), cB + kstep, voffB); PG8_STAGE(PG8_SA(1, 0), cA + kstep, voffA); PG8_STAGE(PG8_SB(1, 1), cB + hstep + kstep, voffB);
    PG8_WAIT_V(6); PG8_BAR;
    for (;;) {
        const bool has_next = S.next(ui + 1, nxt);
        const char* nA = has_next ? (const char*)g.A + (size_t)nxt.pm * tstep + (size_t)nxt.kofs * 2 : cA; const char* nB = has_next ? (const char*)g.Bt + (size_t)nxt.pn * tstep + (size_t)nxt.kofs * 2 : cB;
        for (int t = 0; t < nt; t += 2) {
            const bool last = (t == nt - 2);
            const char* a1 = cA + (size_t)(t + 1) * kstep;
            const char* a2 = last ? nA : cA + (size_t)(t + 2) * kstep; const char* b2 = last ? nB : cB + (size_t)(t + 2) * kstep;
            const char* a3 = a2 + kstep; const char* b3 = b2 + kstep;
            PG8_LDB(B0, 0, 0); PG8_SCHED; PG8_LDA(At, 0, 0); PG8_STAGE(PG8_SA(1, 1), a1 + hstep, voffA);
            PG8_WAIT_L(8); PG8_BAR; PG8_WAIT_L(0); PG8_MMA(0, 0, At, B0); PG8_BAR; PG8_SCHED;
            PG8_LDB(B1, 0, 1); PG8_STAGE(PG8_SB(0, 0), b2, voffB);
            PG8_BAR; PG8_WAIT_L(0); PG8_MMA(0, 1, At, B1); PG8_BAR;
            PG8_LDA(At, 0, 1); PG8_STAGE(PG8_SA(0, 0), a2, voffA);
            PG8_BAR; PG8_WAIT_L(0); PG8_MMA(1, 0, At, B0); PG8_BAR; PG8_SCHED;
            PG8_STAGE(PG8_SB(0, 1), b2 + hstep, voffB);
            PG8_WAIT_V(6); PG8_BAR; PG8_MMA(1, 1, At, B1); PG8_BAR;
            PG8_LDB(B0, 1, 0); PG8_SCHED; PG8_LDA(At, 1, 0); PG8_STAGE(PG8_SA(0, 1), a2 + hstep, voffA);
            PG8_WAIT_L(8); PG8_BAR; PG8_WAIT_L(0); PG8_MMA(0, 0, At, B0); PG8_BAR; PG8_SCHED;
            PG8_LDB(B1, 1, 1); PG8_STAGE(PG8_SB(1, 0), b3, voffB);
            PG8_BAR; PG8_WAIT_L(0); PG8_MMA(0, 1, At, B1); PG8_BAR;
            PG8_LDA(At, 1, 1); PG8_STAGE(PG8_SA(1, 0), a3, voffA);
            PG8_BAR; PG8_WAIT_L(0); PG8_MMA(1, 0, At, B0); PG8_BAR; PG8_SCHED;
            PG8_STAGE(PG8_SB(1, 1), b3 + hstep, voffB);
            PG8_WAIT_V(6); PG8_BAR; PG8_MMA(1, 1, At, B1); PG8_BAR;
        }
        E(acc, cur, wr, wc, fr, fq);
        if (!has_next) break;
#pragma unroll
        for (int a = 0; a < 2; ++a)
#pragma unroll
            for (int b = 0; b < 2; ++b)
#pragma unroll
                for (int m = 0; m < 4; ++m)
#pragma unroll
                    for (int n = 0; n < 2; ++n) acc[a][b][m][n] = (f32x4){0.f, 0.f, 0.f, 0.f};
        cur = nxt; cA = nA; cB = nB; ++ui;
    }
    PG8_WAIT_V(0);
    if (wr == 0) PG8_BAR;
    PG8_BAR;
#undef PG8_SA
#undef PG8_SB
#undef PG8_STAGE
#undef PG8_LDA
#undef PG8_LDB
#undef PG8_MMA
#undef PG8_WAIT_V
#undef PG8_WAIT_L
#undef PG8_BAR
#undef PG8_SCHED
}
}

struct TileInfo { const float* src; bf16_t* dst; int K, N, k0, n0, mode; };
constexpr int CONV_TILES_LAYER = 6 * 1408 + 2320 + 768;

__device__ __forceinline__ void conv_decode(const Params& p, int t, TileInfo& ti) {
    const int layer = t / CONV_TILES_LAYER; int r = t % CONV_TILES_LAYER;
    unsigned char* wl = p.ws + (size_t)layer * SZ_LAYERW;
    int ntn;
    if (r < 1408)       { ti.src = p.in[6]  + (size_t)layer * 2048 * 5632; ti.dst = (bf16_t*)(wl + OFF_WGU1); ti.K = 2048; ti.N = 5632; ti.mode = 1; ntn = 88; }
    else if (r < 2816)  { r -= 1408; ti.src = p.in[7]  + (size_t)layer * 2048 * 5632; ti.dst = (bf16_t*)(wl + OFF_WGU1); ti.K = 2048; ti.N = 5632; ti.mode = 2; ntn = 88; }
    else if (r < 4224)  { r -= 2816; ti.src = p.in[8]  + (size_t)layer * 5632 * 2048; ti.dst = (bf16_t*)(wl + OFF_WD1);  ti.K = 5632; ti.N = 2048; ti.mode = 0; ntn = 32; }
    else if (r < 6544)  { r -= 4224; ti.src = p.in[10] + (size_t)layer * 2048 * N_IN; ti.dst = (bf16_t*)(wl + OFF_WIN);  ti.K = 2048; ti.N = N_IN; ti.mode = 0; ntn = 145; }
    else if (r < 7312)  { r -= 6544; ti.src = p.in[18] + (size_t)layer * 3072 * 2048; ti.dst = (bf16_t*)(wl + OFF_WOUT); ti.K = 3072; ti.N = 2048; ti.mode = 0; ntn = 32; }
    else if (r < 8720)  { r -= 7312; ti.src = p.in[20] + (size_t)layer * 2048 * 5632; ti.dst = (bf16_t*)(wl + OFF_WGU2); ti.K = 2048; ti.N = 5632; ti.mode = 1; ntn = 88; }
    else if (r < 10128) { r -= 8720; ti.src = p.in[21] + (size_t)layer * 2048 * 5632; ti.dst = (bf16_t*)(wl + OFF_WGU2); ti.K = 2048; ti.N = 5632; ti.mode = 2; ntn = 88; }
    else                { r -= 10128; ti.src = p.in[22] + (size_t)layer * 5632 * 2048; ti.dst = (bf16_t*)(wl + OFF_WD2);  ti.K = 5632; ti.N = 2048; ti.mode = 0; ntn = 32; }
    ti.k0 = (r / ntn) * 128; ti.n0 = (r % ntn) * 64;
}
__device__ __forceinline__ void conv_load(const TileInfo& ti, f32x4 (&r)[4], int tid) {
    const int n = ti.n0 + (tid & 15) * 4, kr = tid >> 4;
#pragma unroll
    for (int i = 0; i < 4; ++i) {
        if (n < ti.N) r[i] = __builtin_nontemporal_load((const f32x4*)(ti.src + (size_t)(ti.k0 + kr + 32 * i) * ti.N + n));
        else r[i] = (f32x4){0.f, 0.f, 0.f, 0.f};
    }
}
__device__ void phase_convert(const Params& p, unsigned char* lds_raw) {
    float* T = (float*)lds_raw;
    const int tid = opaque_tid();
    constexpr int NT_TOTAL = 2 * CONV_TILES_LAYER;
    f32x4 r[4]; TileInfo ti;
    int t = blockIdx.x;
    if (t < NT_TOTAL) { conv_decode(p, t, ti); conv_load(ti, r, tid); }
    for (; t < NT_TOTAL; t += gridDim.x) {
        { const int n4 = (tid & 15) * 4, kr = tid >> 4;
#pragma unroll
          for (int i = 0; i < 4; ++i)
#pragma unroll
              for (int j = 0; j < 4; ++j) T[(n4 + j) * 132 + kr + 32 * i] = r[i][j]; }
        __syncthreads();
        const TileInfo cur = ti;
        const int tn = t + gridDim.x;
        if (tn < NT_TOTAL) { conv_decode(p, tn, ti); conv_load(ti, r, tid); }
#pragma unroll
        for (int i = 0; i < 2; ++i) {
            const int nl = (tid >> 4) + 32 * i, k8 = (tid & 15) * 8, n = cur.n0 + nl;
            if (n < cur.N) {
                const f32x4 a = *(const f32x4*)(T + nl * 132 + k8), b = *(const f32x4*)(T + nl * 132 + k8 + 4);
                u32x4 w; w.x = cvt_pk_bf16(a[0], a[1]); w.y = cvt_pk_bf16(a[2], a[3]); w.z = cvt_pk_bf16(b[0], b[1]); w.w = cvt_pk_bf16(b[2], b[3]);
                int row = n;
                if (cur.mode == 1) row = (n >> 7) * 256 + (n & 127);
                else if (cur.mode == 2) row = (n >> 7) * 256 + 128 + (n & 127);
                *(u32x4*)(cur.dst + (size_t)row * cur.K + cur.k0 + k8) = w;
            }
        }
        __syncthreads();
    }
    for (int layer = 0; layer < 2; ++layer) {
        u32x4* z = (u32x4*)(p.ws + (size_t)layer * SZ_LAYERW + OFF_WIN + (size_t)N_IN * 2048 * 2);
        const int n16 = (N_IN_PAD - N_IN) * 2048 * 2 / 16;
        for (int i = blockIdx.x * NTHREADS + tid; i < n16; i += gridDim.x * NTHREADS) z[i] = (u32x4){0u, 0u, 0u, 0u};
    }
}

template <int MODE>
__device__ void phase_norm(const Params& p, const float* gamma) {
    const int tid = opaque_tid(), lane = tid & 63, wave = tid >> 6;
    float* X = (float*)(p.ws + WS_X); bf16_t* H = (bf16_t*)(p.ws + WS_H);
    f32x4 g[8];
#pragma unroll
    for (int i = 0; i < 8; ++i) g[i] = *(const f32x4*)(gamma + i * 256 + lane * 4);
    for (int r = blockIdx.x * 8 + wave; r < M_ROWS; r += gridDim.x * 8) {
        const float* src = (MODE == 0) ? (r < 8192 ? p.in[0] + (size_t)r * 2048 : p.in[1] + (size_t)(r - 8192) * 2048) : X + (size_t)r * 2048;
        f32x4 v[8]; float ss = 0.f;
#pragma unroll
        for (int i = 0; i < 8; ++i) v[i] = *(const f32x4*)(src + i * 256 + lane * 4);
#pragma unroll
        for (int i = 0; i < 8; ++i) ss += v[i][0] * v[i][0] + v[i][1] * v[i][1] + v[i][2] * v[i][2] + v[i][3] * v[i][3];
#pragma unroll
        for (int o = 32; o >= 1; o >>= 1) ss += __shfl_xor(ss, o);
        const float rstd = rsqrtf(ss * (1.f / 2048.f) + EPS);
#pragma unroll
        for (int i = 0; i < 8; ++i) {
            if (MODE == 0) *(f32x4*)(X + (size_t)r * 2048 + i * 256 + lane * 4) = v[i];
            const f32x4 o = v[i] * rstd * g[i];
            if (MODE < 2) { u32x2 w; w.x = cvt_pk_bf16(o[0], o[1]); w.y = cvt_pk_bf16(o[2], o[3]); *(u32x2*)(H + (size_t)r * 2048 + i * 256 + lane * 4) = w; }
            else *(f32x4*)(p.out + (size_t)r * 2048 + i * 256 + lane * 4) = o;
        }
    }
}

__device__ __forceinline__ u32x4 fetch_xbc8(const bf16_t* proj, const float* hist, int c, int lrow, int col) {
    if (lrow >= 0 || (c > 0 && c < NPCH)) return *(const u32x4*)(proj + (size_t)(c * 64 + lrow) * PROJ_LD + 5120 + col);
    if (c == 0) return (u32x4){0u, 0u, 0u, 0u};
    const float* h = hist + ((size_t)(c - NPCH) * 3 + (3 + lrow)) * 4096 + col;
    const f32x4 a = *(const f32x4*)h, b = *(const f32x4*)(h + 4);
    u32x4 w; w.x = cvt_pk_bf16(a[0], a[1]); w.y = cvt_pk_bf16(a[2], a[3]); w.z = cvt_pk_bf16(b[0], b[1]); w.w = cvt_pk_bf16(b[2], b[3]);
    return w;
}
__device__ __forceinline__ void dt_acum(const Params& p, int layer, int c, int h, int lane, float& dtv, float& acum, float& total) {
    const float* DT = (const float*)(p.ws + WS_DT);
    const float raw = DT[(size_t)(c * 64 + lane) * 32 + h];
    dtv = softplus_f(raw + p.in[14][layer * 32 + h]);
    const float A = -expf(p.in[15][layer * 32 + h]);
    float a = dtv * A;
#pragma unroll
    for (int o = 1; o < 64; o <<= 1) { const float t = __shfl_up(a, o); if (lane >= o) a += t; }
    acum = a; total = __shfl(a, 63);
}

__device__ void phase_s1(const Params& p, int layer, unsigned char* lds) {
    bf16_t* s_xwT = (bf16_t*)lds;
    bf16_t* s_BT = (bf16_t*)(lds + 36864);
    float* s_w = (float*)(lds + 55296);
    const int tid = opaque_tid(), lane = tid & 63, wave = tid >> 6, fr = lane & 15, fq = lane >> 4;
    const bf16_t* proj = (const bf16_t*)(p.ws + WS_PROJ);
    bf16_t* mix = (bf16_t*)(p.ws + WS_MIX);
    bf16_t* ST = (bf16_t*)(p.ws + WS_ST);
    float* DEC = (float*)(p.ws + WS_DEC);
    const float* hist = p.in[3] + (size_t)layer * 8 * 3 * 4096;
    for (int unit = blockIdx.x; unit < NCHUNK * 8; unit += gridDim.x) {
        const int c = unit >> 3, g = unit & 7, row0 = c * 64;
        const bool last_chunk = (c >= NPCH - 1);
        if (wave < 4) {
            const int h = g * 4 + wave; float dtv, acum, total;
            dt_acum(p, layer, c, h, lane, dtv, acum, total);
            s_w[wave * 64 + lane] = dtv * __expf(total - acum);
            if (lane == 0) DEC[c * 32 + h] = __expf(total);
        }
        __syncthreads();
        if (tid < 384) {
            const int rr = tid & 7, cg = tid >> 3, l0 = rr * 8;
            const int col = (cg < 32) ? g * 256 + cg * 8 : 2048 + g * 128 + (cg - 32) * 8;
            u32x4 rows[11];
#pragma unroll
            for (int i = 0; i < 11; ++i) rows[i] = fetch_xbc8(proj, hist, c, l0 - 3 + i, col);
            const float* cw = p.in[12] + (size_t)layer * 4 * 4096 + col; const float* cb = p.in[13] + (size_t)layer * 4096 + col;
            float w[4][8], b[8];
#pragma unroll
            for (int k = 0; k < 4; ++k) { const f32x4 a = *(const f32x4*)(cw + k * 4096), bb = *(const f32x4*)(cw + k * 4096 + 4);
#pragma unroll
                for (int j = 0; j < 4; ++j) { w[k][j] = a[j]; w[k][4 + j] = bb[j]; } }
            { const f32x4 a = *(const f32x4*)cb, bb = *(const f32x4*)(cb + 4);
#pragma unroll
              for (int j = 0; j < 4; ++j) { b[j] = a[j]; b[4 + j] = bb[j]; } }
            float sc[8];
#pragma unroll
            for (int i = 0; i < 8; ++i) sc[i] = (cg < 32) ? s_w[(cg >> 3) * 64 + l0 + i] : 1.f;
            bf16_t* dstT = (cg < 32) ? s_xwT + (cg * 8) * 72 + l0 : s_BT + ((cg - 32) * 8) * 72 + l0;
#pragma unroll
            for (int j = 0; j < 8; ++j) {
                float o[8];
#pragma unroll
                for (int i = 0; i < 8; ++i) {
                    float v = b[j];
#pragma unroll
                    for (int k = 0; k < 4; ++k) v += w[k][j] * bfv(rows[i + k], j);
                    o[i] = silu_f(v) * sc[i];
                }
                u32x4 pk; pk.x = cvt_pk_bf16(o[0], o[1]); pk.y = cvt_pk_bf16(o[2], o[3]); pk.z = cvt_pk_bf16(o[4], o[5]); pk.w = cvt_pk_bf16(o[6], o[7]);
                *(u32x4*)(dstT + j * 72) = pk;
            }
        } else {
            const int t2 = tid - 384, rr = t2 & 7, cgi = t2 >> 3, l0 = rr * 8, ch0 = g * 128 + cgi * 8;
            const float* scw = p.in[11] + (size_t)layer * 3 * 1024 + ch0;
            float w[3][8];
#pragma unroll
            for (int k = 0; k < 3; ++k) { const f32x4 a = *(const f32x4*)(scw + k * 1024), bb = *(const f32x4*)(scw + k * 1024 + 4);
#pragma unroll
                for (int j = 0; j < 4; ++j) { w[k][j] = a[j]; w[k][4 + j] = bb[j]; } }
            float um2[8], um1[8], u0[8];
#pragma unroll
            for (int i = 0; i < 10; ++i) {
                const int lrow = l0 - 2 + i;
#pragma unroll
                for (int j = 0; j < 8; ++j) { um2[j] = um1[j]; um1[j] = u0[j]; }
                if (lrow >= 0 || (c > 0 && c < NPCH)) {
                    const bf16_t* rp = proj + (size_t)(row0 + lrow) * PROJ_LD + ch0;
                    const u32x4 cv = *(const u32x4*)(rp + 1024), xv = *(const u32x4*)(rp + 2048);
#pragma unroll
                    for (int j = 0; j < 8; ++j) u0[j] = bfv(cv, j) * bfv(xv, j);
                } else if (c == 0) {
#pragma unroll
                    for (int j = 0; j < 8; ++j) u0[j] = 0.f;
                } else {
                    const float* hp = p.in[2] + (((size_t)layer * 8 + (c - NPCH)) * 2 + (2 + lrow)) * 1024 + ch0;
                    const f32x4 a = *(const f32x4*)hp, bb = *(const f32x4*)(hp + 4);
#pragma unroll
                    for (int j = 0; j < 4; ++j) { u0[j] = a[j]; u0[4 + j] = bb[j]; }
                }
                if (i >= 2) {
                    const int l = l0 + i - 2;
                    const u32x4 bv = *(const u32x4*)(proj + (size_t)(row0 + l) * PROJ_LD + ch0);
                    float y[8];
#pragma unroll
                    for (int j = 0; j < 8; ++j) y[j] = bfv(bv, j) * (w[0][j] * um2[j] + w[1][j] * um1[j] + w[2][j] * u0[j]);
                    u32x4 pk; pk.x = cvt_pk_bf16(y[0], y[1]); pk.y = cvt_pk_bf16(y[2], y[3]); pk.z = cvt_pk_bf16(y[4], y[5]); pk.w = cvt_pk_bf16(y[6], y[7]);
                    *(u32x4*)(mix + (size_t)(row0 + l) * D_MIX + ch0) = pk;
                    if (last_chunk && l >= 62) {
                        float* op = (c < NPCH) ? p.out + O_SC_P + ((size_t)layer * 2 + (l - 62)) * 1024 + ch0
                                               : p.out + O_SC_S + (((size_t)layer * 8 + (c - NPCH)) * 2 + (l - 62)) * 1024 + ch0;
                        *(f32x4*)op = (f32x4){u0[0], u0[1], u0[2], u0[3]}; *(f32x4*)(op + 4) = (f32x4){u0[4], u0[5], u0[6], u0[7]};
                    }
                }
            }
        }
        __syncthreads();
        {
            const int hh = wave >> 1, half = wave & 1, h = g * 4 + hh;
            f32x4 acc[4][4];
#pragma unroll
            for (int a = 0; a < 4; ++a)
#pragma unroll
                for (int b = 0; b < 4; ++b) acc[a][b] = (f32x4){0.f, 0.f, 0.f, 0.f};
#pragma unroll
            for (int ks = 0; ks < 2; ++ks) {
                bf16x8 af[4], bfr[4];
#pragma unroll
                for (int a = 0; a < 4; ++a) af[a] = *(const bf16x8*)(s_BT + (half * 64 + a * 16 + fr) * 72 + ks * 32 + fq * 8);
#pragma unroll
                for (int b = 0; b < 4; ++b) bfr[b] = *(const bf16x8*)(s_xwT + (hh * 64 + b * 16 + fr) * 72 + ks * 32 + fq * 8);
#pragma unroll
                for (int a = 0; a < 4; ++a)
#pragma unroll
                    for (int b = 0; b < 4; ++b) acc[a][b] = __builtin_amdgcn_mfma_f32_16x16x32_bf16(af[a], bfr[b], acc[a][b], 0, 0, 0);
            }
            bf16_t* stp = ST + ((size_t)(c * 32 + h) * 64) * 128;
#pragma unroll
            for (int a = 0; a < 4; ++a)
#pragma unroll
                for (int b = 0; b < 4; ++b) {
                    u32x2 w; w.x = cvt_pk_bf16(acc[a][b][0], acc[a][b][1]); w.y = cvt_pk_bf16(acc[a][b][2], acc[a][b][3]);
                    *(u32x2*)(stp + (size_t)(b * 16 + fr) * 128 + half * 64 + a * 16 + fq * 4) = w;
                }
        }
        __syncthreads();
    }
}

__device__ void phase_s2(const Params& p, int layer) {
    unsigned* ST32 = (unsigned*)(p.ws + WS_ST);
    const float* DEC = (const float*)(p.ws + WS_DEC);
    constexpr int NP = 32 * 64 * 128 / 2;
    const int gtid = blockIdx.x * NTHREADS + opaque_tid(), nth = gridDim.x * NTHREADS;
    for (int idx = gtid; idx < NP; idx += nth) {
        const int h = idx >> 12;
        float s0 = 0.f, s1 = 0.f;
        for (int c0 = 0; c0 < NPCH; c0 += 8) {
            unsigned v[8]; float d[8];
#pragma unroll
            for (int j = 0; j < 8; ++j) { v[j] = ST32[(size_t)(c0 + j) * NP + idx]; d[j] = DEC[(c0 + j) * 32 + h]; }
#pragma unroll
            for (int j = 0; j < 8; ++j) {
                ST32[(size_t)(c0 + j) * NP + idx] = cvt_pk_bf16(s0, s1);
                s0 = s0 * d[j] + bf_lo(v[j]); s1 = s1 * d[j] + bf_hi(v[j]);
            }
        }
        *(f32x2*)(p.out + O_SSM_P + (size_t)layer * 262144 + 2 * (size_t)idx) = (f32x2){s0, s1};
    }
    for (int it = gtid; it < 8 * NP; it += nth) {
        const int b = it / NP, idx = it % NP, h = idx >> 12;
        const f32x2 s = *(const f32x2*)(p.in[4] + ((size_t)layer * 8 + b) * 262144 + 2 * (size_t)idx);
        const unsigned v = ST32[(size_t)(NPCH + b) * NP + idx];
        const float d = DEC[(NPCH + b) * 32 + h];
        ST32[(size_t)(NPCH + b) * NP + idx] = cvt_pk_bf16(s[0], s[1]);
        *(f32x2*)(p.out + O_SSM_S + ((size_t)layer * 8 + b) * 262144 + 2 * (size_t)idx) = (f32x2){s[0] * d + bf_lo(v), s[1] * d + bf_hi(v)};
    }
}

__device__ void phase_s3(const Params& p, int layer, unsigned char* lds) {
    bf16_t* s_xsT = (bf16_t*)lds;
    bf16_t* s_B = (bf16_t*)(lds + 36864);
    bf16_t* s_C = (bf16_t*)(lds + 36864 + 17408);
    bf16_t* s_M = (bf16_t*)(lds + 71680);
    float* s_dt = (float*)(lds + 108544);
    float* s_acum = s_dt + 256;
    float* s_ssq = s_acum + 256;
    const int tid = opaque_tid(), lane = tid & 63, wave = tid >> 6, fr = lane & 15, fq = lane >> 4;
    const bf16_t* proj = (const bf16_t*)(p.ws + WS_PROJ);
    bf16_t* mix = (bf16_t*)(p.ws + WS_MIX);
    const bf16_t* ST = (const bf16_t*)(p.ws + WS_ST);
    const float* hist = p.in[3] + (size_t)layer * 8 * 3 * 4096;
    for (int unit = blockIdx.x; unit < NCHUNK * 8; unit += gridDim.x) {
        const int c = unit >> 3, g = unit & 7, row0 = c * 64;
        const bool last_chunk = (c >= NPCH - 1);
        if (wave < 4) {
            const int h = g * 4 + wave; float dtv, acum, total;
            dt_acum(p, layer, c, h, lane, dtv, acum, total);
            s_dt[wave * 64 + lane] = dtv; s_acum[wave * 64 + lane] = acum;
        }
        if (tid < 64) s_ssq[tid] = 0.f;
        {
            const int rr = tid & 7, cg = tid >> 3, l0 = rr * 8;
            const int col = (cg < 32) ? g * 256 + cg * 8 : (cg < 48 ? 2048 + g * 128 + (cg - 32) * 8 : 3072 + g * 128 + (cg - 48) * 8);
            u32x4 rows[11];
#pragma unroll
            for (int i = 0; i < 11; ++i) rows[i] = fetch_xbc8(proj, hist, c, l0 - 3 + i, col);
            const float* cw = p.in[12] + (size_t)layer * 4 * 4096 + col; const float* cb = p.in[13] + (size_t)layer * 4096 + col;
            float w[4][8], b[8];
#pragma unroll
            for (int k = 0; k < 4; ++k) { const f32x4 a = *(const f32x4*)(cw + k * 4096), bb = *(const f32x4*)(cw + k * 4096 + 4);
#pragma unroll
                for (int j = 0; j < 4; ++j) { w[k][j] = a[j]; w[k][4 + j] = bb[j]; } }
            { const f32x4 a = *(const f32x4*)cb, bb = *(const f32x4*)(cb + 4);
#pragma unroll
              for (int j = 0; j < 4; ++j) { b[j] = a[j]; b[4 + j] = bb[j]; } }
            if (last_chunk && rr == 7) {
#pragma unroll
                for (int i = 0; i < 3; ++i) {
                    float* op = (c < NPCH) ? p.out + O_CONV_P + ((size_t)layer * 3 + i) * 4096 + col
                                           : p.out + O_CONV_S + (((size_t)layer * 8 + (c - NPCH)) * 3 + i) * 4096 + col;
                    const u32x4 rv = rows[8 + i];
                    *(f32x4*)op = (f32x4){bf_lo(rv.x), bf_hi(rv.x), bf_lo(rv.y), bf_hi(rv.y)}; *(f32x4*)(op + 4) = (f32x4){bf_lo(rv.z), bf_hi(rv.z), bf_lo(rv.w), bf_hi(rv.w)};
                }
            }
            if (cg < 32) {
#pragma unroll
                for (int j = 0; j < 8; ++j) {
                    float o[8];
#pragma unroll
                    for (int i = 0; i < 8; ++i) {
                        float v = b[j];
#pragma unroll
                        for (int k = 0; k < 4; ++k) v += w[k][j] * bfv(rows[i + k], j);
                        o[i] = silu_f(v);
                    }
                    u32x4 pk; pk.x = cvt_pk_bf16(o[0], o[1]); pk.y = cvt_pk_bf16(o[2], o[3]); pk.z = cvt_pk_bf16(o[4], o[5]); pk.w = cvt_pk_bf16(o[6], o[7]);
                    *(u32x4*)(s_xsT + (cg * 8 + j) * 72 + l0) = pk;
                }
            } else {
                bf16_t* dst = (cg < 48) ? s_B + (cg - 32) * 8 : s_C + (cg - 48) * 8;
#pragma unroll
                for (int i = 0; i < 8; ++i) {
                    float o[8];
#pragma unroll
                    for (int j = 0; j < 8; ++j) {
                        float v = b[j];
#pragma unroll
                        for (int k = 0; k < 4; ++k) v += w[k][j] * bfv(rows[i + k], j);
                        o[j] = silu_f(v);
                    }
                    u32x4 pk; pk.x = cvt_pk_bf16(o[0], o[1]); pk.y = cvt_pk_bf16(o[2], o[3]); pk.z = cvt_pk_bf16(o[4], o[5]); pk.w = cvt_pk_bf16(o[6], o[7]);
                    *(u32x4*)(dst + (l0 + i) * 136) = pk;
                }
            }
        }
        __syncthreads();
        {
            const int lt = wave >> 1;
#pragma unroll
            for (int sti = 0; sti < 2; ++sti) {
                const int st = (wave & 1) * 2 + sti;
                f32x4 acc = (f32x4){0.f, 0.f, 0.f, 0.f};
                if (st <= lt) {
#pragma unroll
                    for (int ks = 0; ks < 4; ++ks) {
                        const bf16x8 a = *(const bf16x8*)(s_C + (lt * 16 + fr) * 136 + ks * 32 + fq * 8);
                        const bf16x8 b = *(const bf16x8*)(s_B + (st * 16 + fr) * 136 + ks * 32 + fq * 8);
                        acc = __builtin_amdgcn_mfma_f32_16x16x32_bf16(a, b, acc, 0, 0, 0);
                    }
                }
                const int s = st * 16 + fr;
#pragma unroll
                for (int hh = 0; hh < 4; ++hh) {
                    const float as = s_acum[hh * 64 + s], ds = s_dt[hh * 64 + s], Dh = p.in[16][layer * 32 + g * 4 + hh];
#pragma unroll
                    for (int r = 0; r < 4; ++r) {
                        const int l = lt * 16 + fq * 4 + r;
                        float v = 0.f;
                        if (s <= l) v = acc[r] * __expf(s_acum[hh * 64 + l] - as) * ds;
                        if (s == l) v += Dh;
                        s_M[(hh * 64 + l) * 72 + s] = (bf16_t)(cvt_pk_bf16(v, 0.f) & 0xffffu);
                    }
                }
            }
        }
        __syncthreads();
        {
            const int hh = wave >> 1, half = wave & 1, h = g * 4 + hh;
            u32x2 zv[2][4];
#pragma unroll
            for (int lti = 0; lti < 2; ++lti)
#pragma unroll
                for (int pt = 0; pt < 4; ++pt) zv[lti][pt] = *(const u32x2*)(proj + (size_t)(row0 + (2 * half + lti) * 16 + fr) * PROJ_LD + 3072 + h * 64 + pt * 16 + fq * 4);
            f32x4 acc1[2][4], acc2[2][4];
#pragma unroll
            for (int a = 0; a < 2; ++a)
#pragma unroll
                for (int b = 0; b < 4; ++b) { acc1[a][b] = (f32x4){0.f, 0.f, 0.f, 0.f}; acc2[a][b] = (f32x4){0.f, 0.f, 0.f, 0.f}; }
            const bf16_t* prev = ST + ((size_t)(c * 32 + h) * 64) * 128;
#pragma unroll
            for (int ks = 0; ks < 4; ++ks) {
                bf16x8 bC[2], aP[4];
#pragma unroll
                for (int pt = 0; pt < 4; ++pt) aP[pt] = *(const bf16x8*)(prev + (size_t)(pt * 16 + fr) * 128 + ks * 32 + fq * 8);
#pragma unroll
                for (int lti = 0; lti < 2; ++lti) bC[lti] = *(const bf16x8*)(s_C + ((2 * half + lti) * 16 + fr) * 136 + ks * 32 + fq * 8);
#pragma unroll
                for (int lti = 0; lti < 2; ++lti)
#pragma unroll
                    for (int pt = 0; pt < 4; ++pt) acc2[lti][pt] = __builtin_amdgcn_mfma_f32_16x16x32_bf16(aP[pt], bC[lti], acc2[lti][pt], 0, 0, 0);
            }
#pragma unroll
            for (int ks = 0; ks < 2; ++ks) {
                bf16x8 bM[2], aX[4];
#pragma unroll
                for (int lti = 0; lti < 2; ++lti) bM[lti] = *(const bf16x8*)(s_M + (hh * 64 + (2 * half + lti) * 16 + fr) * 72 + ks * 32 + fq * 8);
#pragma unroll
                for (int pt = 0; pt < 4; ++pt) aX[pt] = *(const bf16x8*)(s_xsT + (hh * 64 + pt * 16 + fr) * 72 + ks * 32 + fq * 8);
#pragma unroll
                for (int lti = 0; lti < 2; ++lti)
#pragma unroll
                    for (int pt = 0; pt < 4; ++pt) acc1[lti][pt] = __builtin_amdgcn_mfma_f32_16x16x32_bf16(aX[pt], bM[lti], acc1[lti][pt], 0, 0, 0);
            }
#pragma unroll
            for (int lti = 0; lti < 2; ++lti) {
                const int l = (2 * half + lti) * 16 + fr;
                const float e = __expf(s_acum[hh * 64 + l]);
                float ss = 0.f;
#pragma unroll
                for (int pt = 0; pt < 4; ++pt) {
                    const float z0 = bf_lo(zv[lti][pt].x), z1 = bf_hi(zv[lti][pt].x), z2 = bf_lo(zv[lti][pt].y), z3 = bf_hi(zv[lti][pt].y);
                    f32x4 u = acc1[lti][pt] + e * acc2[lti][pt];
                    u[0] *= silu_f(z0); u[1] *= silu_f(z1); u[2] *= silu_f(z2); u[3] *= silu_f(z3);
                    acc1[lti][pt] = u;
                    ss += u[0] * u[0] + u[1] * u[1] + u[2] * u[2] + u[3] * u[3];
                }
                ss += __shfl_xor(ss, 16); ss += __shfl_xor(ss, 32);
                if (fq == 0) atomicAdd(&s_ssq[l], ss);
            }
            __syncthreads();
            const float* nw = p.in[17] + (size_t)layer * 2048 + h * 64;
#pragma unroll
            for (int lti = 0; lti < 2; ++lti) {
                const int l = (2 * half + lti) * 16 + fr;
                const float scale = rsqrtf(s_ssq[l] * (1.f / 256.f) + EPS);
#pragma unroll
                for (int pt = 0; pt < 4; ++pt) {
                    const f32x4 w4 = *(const f32x4*)(nw + pt * 16 + fq * 4);
                    const f32x4 o = acc1[lti][pt] * scale * w4;
                    u32x2 w; w.x = cvt_pk_bf16(o[0], o[1]); w.y = cvt_pk_bf16(o[2], o[3]);
                    *(u32x2*)(mix + (size_t)(row0 + l) * D_MIX + 1024 + h * 64 + pt * 16 + fq * 4) = w;
                }
            }
        }
        __syncthreads();
    }
}

__global__ void __launch_bounds__(NTHREADS, 2) fwd_kernel(Params p) {
    extern __shared__ __attribute__((aligned(16))) unsigned char lds_raw[];
    LAS unsigned char* lds = (LAS unsigned char*)lds_raw;
    float* X = (float*)(p.ws + WS_X); bf16_t* H = (bf16_t*)(p.ws + WS_H); bf16_t* ACT = (bf16_t*)(p.ws + WS_PROJ); bf16_t* PROJ = (bf16_t*)(p.ws + WS_PROJ);
    bf16_t* MIX = (bf16_t*)(p.ws + WS_MIX); float* DT = (float*)(p.ws + WS_DT);
    const int G = gridDim.x, cblk = blockIdx.x;
    for (int ph = p.ph_lo; ph < p.ph_hi; ++ph) {
        if (ph == 0) {
            phase_convert(p, lds_raw);
            phase_norm<0>(p, p.in[5]);
        } else {
            const int layer = (ph - 1) / 12, sub = (ph - 1) % 12;
            unsigned char* wl = p.ws + (size_t)layer * SZ_LAYERW;
            if (sub == 0 || sub == 9) {
                pg8::Gemm g{H, (const bf16_t*)(wl + (sub == 0 ? OFF_WGU1 : OFF_WGU2)), M_ROWS, 11264, 2048, 2048};
                typedef pg8::SplitOrder<M_ROWS, 11264, 1, 2048> SO; SO S; S.init(G, cblk);
                pg8::EpiSwiglu E{ACT};
                pg8::gemm_phase<pg8::EpiSwiglu, SO, 2048, 2048>(lds, g, S, E);
            } else if (sub == 1 || sub == 10) {
                pg8::Gemm g{ACT, (const bf16_t*)(wl + (sub == 1 ? OFF_WD1 : OFF_WD2)), M_ROWS, 2048, D_FF, D_FF / 4};
                typedef pg8::SplitOrder<M_ROWS, 2048, 1, D_FF> SO; SO S; S.init(G, cblk);
                pg8::EpiAtomic E{X, 0.5f};
                pg8::gemm_phase<pg8::EpiAtomic, SO, D_FF, D_FF>(lds, g, S, E);
            } else if (sub == 7) {
                pg8::Gemm g{MIX, (const bf16_t*)(wl + OFF_WOUT), M_ROWS, 2048, D_MIX, D_MIX / 4};
                typedef pg8::SplitOrder<M_ROWS, 2048, 1, D_MIX> SO; SO S; S.init(G, cblk);
                pg8::EpiAtomic E{X, 1.0f};
                pg8::gemm_phase<pg8::EpiAtomic, SO, D_MIX, D_MIX>(lds, g, S, E);
            } else if (sub == 2 || sub == 8) {
                phase_norm<1>(p, (sub == 2 ? p.in[9] : p.in[19]) + (size_t)layer * 2048);
            } else if (sub == 3) {
                pg8::Gemm g{H, (const bf16_t*)(wl + OFF_WIN), M_ROWS, N_IN_PAD, 2048, 2048};
                typedef pg8::SplitOrder<M_ROWS, N_IN_PAD, 1, 2048> SO; SO S; S.init(G, cblk);
                pg8::EpiProj E{PROJ, DT};
                pg8::gemm_phase<pg8::EpiProj, SO, 2048, 2048>(lds, g, S, E);
            } else if (sub == 4) {
                phase_s1(p, layer, lds_raw);
            } else if (sub == 5) {
                phase_s2(p, layer);
            } else if (sub == 6) {
                phase_s3(p, layer, lds_raw);
            } else {
                if (layer == 0) phase_norm<1>(p, p.in[5] + 2048);
                else phase_norm<2>(p, p.in[23]);
            }
        }
        if (ph + 1 < p.ph_hi) cg::this_grid().sync();
    }
}

extern "C" void kernel_launch(void* const* d_in, const int* in_sizes, int n_in, void* d_out, int out_size, void* d_ws, size_t ws_size, hipStream_t stream) {
    static int grid = 0;
    if (grid == 0) {
        int dev = 0, cus = 0, per_cu = 0;
        hipGetDevice(&dev);
        hipDeviceGetAttribute(&cus, hipDeviceAttributeMultiprocessorCount, dev);
        if (hipFuncSetAttribute((const void*)fwd_kernel, hipFuncAttributeMaxDynamicSharedMemorySize, LDS_BYTES) != hipSuccess) fprintf(stderr, "kernel_launch: hipFuncSetAttribute failed\n");
        if (hipOccupancyMaxActiveBlocksPerMultiprocessor(&per_cu, (const void*)fwd_kernel, NTHREADS, LDS_BYTES) != hipSuccess || per_cu < 1) { fprintf(stderr, "kernel_launch: occupancy query says %d\n", per_cu); per_cu = 1; }
        (void)hipGetLastError();
        if (per_cu > 1) per_cu = 1;
        grid = cus * per_cu;
        if (ws_size < WS_END) fprintf(stderr, "kernel_launch: workspace too small: %zu < %zu\n", ws_size, (size_t)WS_END);
    }
    Params p{};
    for (int i = 0; i < 24; ++i) p.in[i] = (const float*)d_in[i];
    p.out = (float*)d_out; p.ws = (unsigned char*)d_ws;
#if ONE_LAUNCH
    p.ph_lo = 0; p.ph_hi = 25;
    void* args[] = {&p};
    hipError_t e = hipLaunchCooperativeKernel((const void*)fwd_kernel, dim3(grid), dim3(NTHREADS), args, LDS_BYTES, stream);
    if (e != hipSuccess) fprintf(stderr, "cooperative launch failed: %s (grid %d)\n", hipGetErrorString(e), grid);
#else
#ifndef PH_LIST
#define PH_LIST 0,1,2,3,4,5,6,7,8,9,10,11,12,13,14,15,16,17,18,19,20,21,22,23,24
#endif
    const int phl[] = {PH_LIST};
    for (int ph : phl) {
        p.ph_lo = ph; p.ph_hi = ph + 1;
        hipLaunchKernelGGL(fwd_kernel, dim3(grid), dim3(NTHREADS), LDS_BYTES, stream, p);
    }
#endif
}
```

```cpp
#include <hip/hip_runtime.h>
#include <hip/hip_cooperative_groups.h>
#include <cstdio>
namespace cg = cooperative_groups;

#ifndef ONE_LAUNCH
#define ONE_LAUNCH 1
#endif

#define LAS __attribute__((address_space(3)))
typedef unsigned short bf16_t;
typedef short bf16x8 __attribute__((ext_vector_type(8)));
typedef float f32x4 __attribute__((ext_vector_type(4)));
typedef float f32x2 __attribute__((ext_vector_type(2)));
typedef unsigned u32x4 __attribute__((ext_vector_type(4)));
typedef unsigned u32x2 __attribute__((ext_vector_type(2)));

constexpr int D_MODEL = 2048, M_ROWS = 8704, NCHUNK = 136, NPCH = 128;
constexpr int D_FF = 5632, PROJ_LD = 9216, N_IN = 9248, N_IN_PAD = 9472, D_MIX = 3072;
constexpr int H_LD = 2048 + 64, ACT_LD = D_FF + 64, MIX_LD = D_MIX + 64;
constexpr float EPS = 1e-6f;
constexpr int NTHREADS = 512;
constexpr int LDS_BYTES = 131072 + 16;

constexpr size_t O_SC_P = 17825792, O_CONV_P = 17829888, O_SSM_P = 17854464, O_SC_S = 18378752, O_CONV_S = 18411520, O_SSM_S = 18608128;

constexpr size_t SZ_WGU = (size_t)11264 * H_LD * 2, SZ_WD = (size_t)2048 * ACT_LD * 2, SZ_WIN = (size_t)N_IN_PAD * H_LD * 2, SZ_WOUT = (size_t)2048 * MIX_LD * 2;
constexpr size_t OFF_WGU1 = 0, OFF_WD1 = SZ_WGU, OFF_WIN = SZ_WGU + SZ_WD, OFF_WOUT = OFF_WIN + SZ_WIN, OFF_WGU2 = OFF_WOUT + SZ_WOUT, OFF_WD2 = OFF_WGU2 + SZ_WGU;
constexpr size_t SZ_LAYERW = 2 * SZ_WGU + 2 * SZ_WD + SZ_WIN + SZ_WOUT;
constexpr size_t WS_X = 2 * SZ_LAYERW;
constexpr size_t WS_H = WS_X + (size_t)M_ROWS * 2048 * 4;
constexpr size_t WS_PROJ = WS_H + (size_t)M_ROWS * H_LD * 2;
constexpr size_t WS_MIX = WS_PROJ + (size_t)M_ROWS * PROJ_LD * 2;
constexpr size_t WS_ST = WS_MIX + (size_t)M_ROWS * MIX_LD * 2;
constexpr size_t WS_DT = WS_ST + (size_t)NCHUNK * 32 * 64 * 128 * 2;
constexpr size_t WS_DEC = WS_DT + (size_t)M_ROWS * 32 * 4;
constexpr size_t WS_CTL = WS_DEC + (size_t)NCHUNK * 32 * 4;
constexpr size_t WS_END = WS_CTL + 16384;

struct Params { const float* in[24]; float* out; unsigned char* ws; int ph_lo, ph_hi; };

__device__ __forceinline__ const float* inp(const Params& p, int i) { asm volatile("" : "+s"(i)); return p.in[i]; }
__device__ __forceinline__ float bf_lo(unsigned u) { return __uint_as_float(u << 16); }
__device__ __forceinline__ float bf_hi(unsigned u) { return __uint_as_float(u & 0xffff0000u); }
typedef __bf16 bf16x2v __attribute__((ext_vector_type(2)));
__device__ __forceinline__ unsigned cvt_pk_bf16(float lo, float hi) { f32x2 v = {lo, hi}; bf16x2v b = __builtin_convertvector(v, bf16x2v); return __builtin_bit_cast(unsigned, b); }
__device__ __forceinline__ float silu_f(float x) { return x * __builtin_amdgcn_rcpf(1.f + __expf(-x)); }
__device__ __forceinline__ float softplus_f(float x) { return x > 20.f ? x : log1pf(expf(x)); }
__device__ __forceinline__ int opaque_tid() { int t = threadIdx.x; asm volatile("" : "+v"(t)); return t; }
__device__ __forceinline__ float bfv(const u32x4& v, int j) { const unsigned w = v[j >> 1]; return (j & 1) ? bf_hi(w) : bf_lo(w); }

namespace pg8 {
constexpr int BM = 256, BK = 64, HALF = 128, HTB = HALF * BK * 2, STAGE_BYTES = 8 * HTB, NXCD = 8, WGM = 8;
__host__ __device__ __forceinline__ int lds_byte(int r, int c) { const int st = (r >> 4) * 2 + (c >> 5), rr = r & 15, cc = c & 31, ob = rr * 64 + cc * 2; return st * 1024 + (ob ^ (((ob >> 9) & 1) << 5)); }
__host__ __device__ __forceinline__ void stage_rc(int b, int& R, int& C) { const int st = b / 1024, sb = b % 1024, swz = sb ^ (((sb >> 9) & 1) << 5); R = (st >> 1) * 16 + swz / 64; C = (st & 1) * 32 + (swz % 64) / 2; }
__host__ __device__ __forceinline__ int perm32(int rho) { const int n = rho >> 4, i = rho & 15; return 8 * (i >> 2) + 4 * n + (i & 3); }

struct Unit { int pm, pn, kofs, nt, part; };
struct Gemm { const bf16_t* A; const bf16_t* Bt; int M, N, ld, Kc; };

template <int M, int N, int KS, int Kc>
struct SplitOrder {
    static constexpr int nM = M / BM, nN = N / BM, nwg = nM * nN;
    int G, c;
    __device__ void init(int G_, int c_) { G = G_; c = c_; }
    __device__ bool next(int i, Unit& u) const {
        const int L = i * G + c; if (L >= nwg * KS) return false;
        const int ks = L / nwg; int wgid = L - ks * nwg;
        { const int q = nwg / NXCD, r = nwg % NXCD, xcd = wgid % NXCD, off = wgid / NXCD; wgid = (xcd < r ? xcd * (q + 1) : r * (q + 1) + (xcd - r) * q) + off; }
        const int nig = WGM * nN, gid = wgid / nig, fm = gid * WGM, gsz = (nM - fm) < WGM ? (nM - fm) : WGM;
        u.pm = fm + ((wgid % nig) % gsz); u.pn = (wgid % nig) / gsz; u.kofs = ks * Kc; u.nt = Kc / BK; u.part = -1; return true;
    }
};


template <int K, int KS>
struct MixedOrder {
    static constexpr int nFull = 256, KcP = K / KS;
    int G, c;
    __device__ void init(int G_, int c_) { G = G_; c = c_; }
    __device__ bool next(int i, Unit& u) const {
        const int L = i * G + c;
        if (L < nFull) {
            int wgid = L; { const int q = nFull / NXCD, xcd = wgid % NXCD, off = wgid / NXCD; wgid = xcd * q + off; }
            const int nig = WGM * 8, gid = wgid / nig, fm = gid * WGM;
            u.pm = fm + ((wgid % nig) % WGM); u.pn = (wgid % nig) / WGM; u.kofs = 0; u.nt = K / BK; u.part = -1; return true;
        }
        const int q = L - nFull; if (q >= 16 * KS) return false;
        const int tile = q / KS, ks = q - tile * KS;
        u.pm = 32 + (tile >> 3); u.pn = tile & 7; u.kofs = ks * KcP; u.nt = KcP / BK; u.part = ks; return true;
    }
};

struct EpiSwiglu {
    static constexpr bool PERM = true;
    bf16_t* O;
    __device__ __forceinline__ void operator()(const f32x4 (&acc)[2][2][4][2], const Unit& u, int wr, int wc, int fr, int fq) const {
        const int row0 = u.pm * BM + wr * 64 + fr, col0 = u.pn * 128 + wc * 32 + 8 * fq;
#pragma unroll
        for (int ai = 0; ai < 2; ++ai)
#pragma unroll
            for (int m = 0; m < 4; ++m) {
                bf16_t* rowp = O + (size_t)(row0 + ai * HALF + m * 16) * ACT_LD + col0;
                const f32x4 g0 = acc[ai][0][m][0], g1 = acc[ai][0][m][1], u0 = acc[ai][1][m][0], u1 = acc[ai][1][m][1];
                u32x4 w;
                w.x = cvt_pk_bf16(silu_f(g0[0]) * u0[0], silu_f(g0[1]) * u0[1]); w.y = cvt_pk_bf16(silu_f(g0[2]) * u0[2], silu_f(g0[3]) * u0[3]);
                w.z = cvt_pk_bf16(silu_f(g1[0]) * u1[0], silu_f(g1[1]) * u1[1]); w.w = cvt_pk_bf16(silu_f(g1[2]) * u1[2], silu_f(g1[3]) * u1[3]);
                *(u32x4*)rowp = w;
            }
    }
};
struct EpiAtomic {
    static constexpr bool PERM = false;
    float* X; float* PART; float scale;
    __device__ __forceinline__ void operator()(const f32x4 (&acc)[2][2][4][2], const Unit& u, int wr, int wc, int fr, int fq) const {
        const int row0 = u.pm * BM + wr * 64 + fr, col0 = u.pn * BM + wc * 32 + 4 * fq;
        if (u.part < 0) {
#pragma unroll
            for (int ai = 0; ai < 2; ++ai)
#pragma unroll
                for (int m = 0; m < 4; ++m) {
                    float* rowp = X + (size_t)(row0 + ai * HALF + m * 16) * D_MODEL + col0;
                    f32x4 xv[2][2];
#pragma unroll
                    for (int bj = 0; bj < 2; ++bj)
#pragma unroll
                        for (int n = 0; n < 2; ++n) xv[bj][n] = *(const f32x4*)(rowp + bj * HALF + n * 16);
#pragma unroll
                    for (int bj = 0; bj < 2; ++bj)
#pragma unroll
                        for (int n = 0; n < 2; ++n) *(f32x4*)(rowp + bj * HALF + n * 16) = xv[bj][n] + scale * acc[ai][bj][m][n];
                }
        } else {
            float* base = PART + (size_t)u.part * (512 * 2048);
#pragma unroll
            for (int ai = 0; ai < 2; ++ai)
#pragma unroll
                for (int m = 0; m < 4; ++m) {
                    float* rowp = base + (size_t)(row0 - 8192 + ai * HALF + m * 16) * D_MODEL + col0;
#pragma unroll
                    for (int bj = 0; bj < 2; ++bj)
#pragma unroll
                        for (int n = 0; n < 2; ++n) *(f32x4*)(rowp + bj * HALF + n * 16) = acc[ai][bj][m][n];
                }
        }
    }
};
struct EpiProj {
    static constexpr bool PERM = true;
    bf16_t* P; float* DT;
    __device__ __forceinline__ void operator()(const f32x4 (&acc)[2][2][4][2], const Unit& u, int wr, int wc, int fr, int fq) const {
        const int row0 = u.pm * BM + wr * 64 + fr;
        if (u.pn < 36) {
            const int col0 = u.pn * BM + wc * 32 + 8 * fq;
#pragma unroll
            for (int ai = 0; ai < 2; ++ai)
#pragma unroll
                for (int m = 0; m < 4; ++m) {
                    bf16_t* rowp = P + (size_t)(row0 + ai * HALF + m * 16) * PROJ_LD + col0;
#pragma unroll
                    for (int bj = 0; bj < 2; ++bj) {
                        const f32x4 v0 = acc[ai][bj][m][0], v1 = acc[ai][bj][m][1];
                        u32x4 w; w.x = cvt_pk_bf16(v0[0], v0[1]); w.y = cvt_pk_bf16(v0[2], v0[3]); w.z = cvt_pk_bf16(v1[0], v1[1]); w.w = cvt_pk_bf16(v1[2], v1[3]);
                        *(u32x4*)(rowp + bj * HALF) = w;
                    }
                }
        } else if (wc == 0) {
#pragma unroll
            for (int ai = 0; ai < 2; ++ai)
#pragma unroll
                for (int m = 0; m < 4; ++m) {
                    float* rowp = DT + (size_t)(row0 + ai * HALF + m * 16) * 32 + 8 * fq;
                    *(f32x4*)rowp = acc[ai][0][m][0]; *(f32x4*)(rowp + 4) = acc[ai][0][m][1];
                }
        }
    }
};

template <class Epi, class Sched, int LD>
__device__ __forceinline__ void gemm_phase(LAS unsigned char* lds, const Gemm g, const Sched& S, const Epi& E) {
    const int tid = opaque_tid(), wid = __builtin_amdgcn_readfirstlane(tid >> 6), lane = tid & 63, wr = wid >> 2, wc = wid & 3, fr = lane & 15, fq = lane >> 4;
    constexpr int K = LD;
    unsigned voffA[2], voffB[2];
#pragma unroll
    for (int i = 0; i < 2; ++i) { int R, C; stage_rc(tid * 16 + i * 8192, R, C); const int Rb = Epi::PERM ? ((R & ~31) + perm32(R & 31)) : R;
        voffA[i] = (unsigned)(R * K + C) * 2u; voffB[i] = (unsigned)(Rb * K + C) * 2u; }
    const size_t kstep = (size_t)(BK * 2);
    const size_t hstep = (size_t)HALF * K * 2;
    const size_t tstep = 2 * hstep;
    const unsigned ldsw = (unsigned)wid * 1024u;
    const int aoff = lds_byte(wr * 64 + fr, fq * 8), boff = lds_byte(wc * 32 + fr, fq * 8);
#define PG8_SA(b, h) (((b) * 2 + (h)) * HTB)
#define PG8_SB(b, h) ((4 + (b) * 2 + (h)) * HTB)
#define PG8_STAGE(bufoff, gbase, voff) do { _Pragma("unroll") for (int _i = 0; _i < 2; ++_i) \
        __builtin_amdgcn_global_load_lds((const unsigned*)((const char*)(gbase) + (voff)[_i]), (LAS unsigned*)(lds + (bufoff) + ldsw + _i * 8192), 16, 0, 0); } while (0)
#define PG8_LDA(dst, b, h) do { _Pragma("unroll") for (int m = 0; m < 4; ++m) _Pragma("unroll") for (int k = 0; k < 2; ++k) dst[m][k] = *(const LAS bf16x8*)(lds + PG8_SA(b, h) + aoff + m * 2048 + k * 1024); } while (0)
#define PG8_LDB(dst, b, h) do { _Pragma("unroll") for (int n = 0; n < 2; ++n) _Pragma("unroll") for (int k = 0; k < 2; ++k) dst[n][k] = *(const LAS bf16x8*)(lds + PG8_SB(b, h) + boff + n * 2048 + k * 1024); } while (0)
#define PG8_MMA(ai, bj, At, Bt) do { __builtin_amdgcn_s_setprio(1); _Pragma("unroll") for (int m = 0; m < 4; ++m) _Pragma("unroll") for (int n = 0; n < 2; ++n) _Pragma("unroll") for (int k = 0; k < 2; ++k) \
        acc[ai][bj][m][n] = __builtin_amdgcn_mfma_f32_16x16x32_bf16(Bt[n][k], At[m][k], acc[ai][bj][m][n], 0, 0, 0); __builtin_amdgcn_s_setprio(0); } while (0)
#define PG8_WAIT_V(n) asm volatile("s_waitcnt vmcnt(" #n ")" ::: "memory")
#define PG8_WAIT_L(n) asm volatile("s_waitcnt lgkmcnt(" #n ")" ::: "memory")
#define PG8_BAR __builtin_amdgcn_s_barrier()
#define PG8_SCHED __builtin_amdgcn_sched_barrier(0)
    Unit cur, nxt; int ui = 0;
    if (!S.next(0, cur)) return;
    f32x4 acc[2][2][4][2];
#pragma unroll
    for (int a = 0; a < 2; ++a)
#pragma unroll
        for (int b = 0; b < 2; ++b)
#pragma unroll
            for (int m = 0; m < 4; ++m)
#pragma unroll
                for (int n = 0; n < 2; ++n) acc[a][b][m][n] = (f32x4){0.f, 0.f, 0.f, 0.f};
    bf16x8 At[4][2], B0[2][2], B1[2][2];
    const char* cA = (const char*)g.A + (size_t)cur.pm * tstep + (size_t)cur.kofs * 2; const char* cB = (const char*)g.Bt + (size_t)cur.pn * tstep + (size_t)cur.kofs * 2;
    PG8_STAGE(PG8_SB(0, 0), cB, voffB); PG8_STAGE(PG8_SA(0, 0), cA, voffA); PG8_STAGE(PG8_SB(0, 1), cB + hstep, voffB); PG8_STAGE(PG8_SA(0, 1), cA + hstep, voffA);
    if (wr == 1) PG8_BAR;
    PG8_WAIT_V(4); PG8_BAR;
    PG8_STAGE(PG8_SB(1, 0), cB + kstep, voffB); PG8_STAGE(PG8_SA(1, 0), cA + kstep, voffA); PG8_STAGE(PG8_SB(1, 1), cB + hstep + kstep, voffB);
    PG8_WAIT_V(6); PG8_BAR;
    for (;;) {
        const bool has_next = S.next(ui + 1, nxt);
        const char* nA = has_next ? (const char*)g.A + (size_t)nxt.pm * tstep + (size_t)nxt.kofs * 2 : cA; const char* nB = has_next ? (const char*)g.Bt + (size_t)nxt.pn * tstep + (size_t)nxt.kofs * 2 : cB;
        const int nt = cur.nt;
        for (int t = 0; t < nt; t += 2) {
            const bool last = (t == nt - 2);
            const char* a1 = cA + (size_t)(t + 1) * kstep;
            const char* a2 = last ? nA : cA + (size_t)(t + 2) * kstep; const char* b2 = last ? nB : cB + (size_t)(t + 2) * kstep;
            const char* a3 = a2 + kstep; const char* b3 = b2 + kstep;
            PG8_LDB(B0, 0, 0); PG8_SCHED; PG8_LDA(At, 0, 0); PG8_STAGE(PG8_SA(1, 1), a1 + hstep, voffA);
            PG8_WAIT_L(8); PG8_BAR; PG8_WAIT_L(0); PG8_MMA(0, 0, At, B0); PG8_BAR; PG8_SCHED;
            PG8_LDB(B1, 0, 1); PG8_STAGE(PG8_SB(0, 0), b2, voffB);
            PG8_BAR; PG8_WAIT_L(0); PG8_MMA(0, 1, At, B1); PG8_BAR;
            PG8_LDA(At, 0, 1); PG8_STAGE(PG8_SA(0, 0), a2, voffA);
            PG8_BAR; PG8_WAIT_L(0); PG8_MMA(1, 0, At, B0); PG8_BAR; PG8_SCHED;
            PG8_STAGE(PG8_SB(0, 1), b2 + hstep, voffB);
            PG8_WAIT_V(6); PG8_BAR; PG8_MMA(1, 1, At, B1); PG8_BAR;
            PG8_LDB(B0, 1, 0); PG8_SCHED; PG8_LDA(At, 1, 0); PG8_STAGE(PG8_SA(0, 1), a2 + hstep, voffA);
            PG8_WAIT_L(8); PG8_BAR; PG8_WAIT_L(0); PG8_MMA(0, 0, At, B0); PG8_BAR; PG8_SCHED;
            PG8_LDB(B1, 1, 1); PG8_STAGE(PG8_SB(1, 0), b3, voffB);
            PG8_BAR; PG8_WAIT_L(0); PG8_MMA(0, 1, At, B1); PG8_BAR;
            PG8_LDA(At, 1, 1); PG8_STAGE(PG8_SA(1, 0), a3, voffA);
            PG8_BAR; PG8_WAIT_L(0); PG8_MMA(1, 0, At, B0); PG8_BAR; PG8_SCHED;
            PG8_STAGE(PG8_SB(1, 1), b3 + hstep, voffB);
            PG8_WAIT_V(6); PG8_BAR; PG8_MMA(1, 1, At, B1); PG8_BAR;
        }
        E(acc, cur, wr, wc, fr, fq);
        if (!has_next) break;
#pragma unroll
        for (int a = 0; a < 2; ++a)
#pragma unroll
            for (int b = 0; b < 2; ++b)
#pragma unroll
                for (int m = 0; m < 4; ++m)
#pragma unroll
                    for (int n = 0; n < 2; ++n) acc[a][b][m][n] = (f32x4){0.f, 0.f, 0.f, 0.f};
        cur = nxt; cA = nA; cB = nB; ++ui;
    }
    PG8_WAIT_V(0);
    if (wr == 0) PG8_BAR;
    PG8_BAR;
#undef PG8_SA
#undef PG8_SB
#undef PG8_STAGE
#undef PG8_LDA
#undef PG8_LDB
#undef PG8_MMA
#undef PG8_WAIT_V
#undef PG8_WAIT_L
#undef PG8_BAR
#undef PG8_SCHED
}
}

struct TileInfo { const float* src; bf16_t* dst; int K, N, k0, n0, mode; };
constexpr int CONV_TILES_LAYER = 6 * 352 + 580 + 192;

__device__ __forceinline__ void conv_decode(const Params& p, int t, TileInfo& ti) {
    const int layer = t / CONV_TILES_LAYER; int r = t % CONV_TILES_LAYER;
    unsigned char* wl = p.ws + (size_t)layer * SZ_LAYERW;
    int ntn;
    if (r < 352)       { ti.src = inp(p, 6)  + (size_t)layer * 2048 * 5632; ti.dst = (bf16_t*)(wl + OFF_WGU1); ti.K = 2048; ti.N = 5632; ti.mode = 1; ntn = 88; }
    else if (r < 704)  { r -= 352;  ti.src = inp(p, 7)  + (size_t)layer * 2048 * 5632; ti.dst = (bf16_t*)(wl + OFF_WGU1); ti.K = 2048; ti.N = 5632; ti.mode = 2; ntn = 88; }
    else if (r < 1056) { r -= 704;  ti.src = inp(p, 8)  + (size_t)layer * 5632 * 2048; ti.dst = (bf16_t*)(wl + OFF_WD1);  ti.K = 5632; ti.N = 2048; ti.mode = 0; ntn = 32; }
    else if (r < 1636) { r -= 1056; ti.src = inp(p, 10) + (size_t)layer * 2048 * N_IN; ti.dst = (bf16_t*)(wl + OFF_WIN);  ti.K = 2048; ti.N = N_IN; ti.mode = 0; ntn = 145; }
    else if (r < 1828) { r -= 1636; ti.src = inp(p, 18) + (size_t)layer * 3072 * 2048; ti.dst = (bf16_t*)(wl + OFF_WOUT); ti.K = 3072; ti.N = 2048; ti.mode = 0; ntn = 32; }
    else if (r < 2180) { r -= 1828; ti.src = inp(p, 20) + (size_t)layer * 2048 * 5632; ti.dst = (bf16_t*)(wl + OFF_WGU2); ti.K = 2048; ti.N = 5632; ti.mode = 1; ntn = 88; }
    else if (r < 2532) { r -= 2180; ti.src = inp(p, 21) + (size_t)layer * 2048 * 5632; ti.dst = (bf16_t*)(wl + OFF_WGU2); ti.K = 2048; ti.N = 5632; ti.mode = 2; ntn = 88; }
    else               { r -= 2532; ti.src = inp(p, 22) + (size_t)layer * 5632 * 2048; ti.dst = (bf16_t*)(wl + OFF_WD2);  ti.K = 5632; ti.N = 2048; ti.mode = 0; ntn = 32; }
    ti.k0 = (r / ntn) * 512; ti.n0 = (r % ntn) * 64;
}
__device__ __forceinline__ void conv_load(const TileInfo& ti, f32x4 (&r)[16], int tid) {
    const int lane = tid & 63, wave = tid >> 6, n = ti.n0 + (lane & 15) * 4, k = ti.k0 + wave * 64 + (lane >> 4) * 16;
#pragma unroll
    for (int i = 0; i < 16; ++i) {
        if (n < ti.N) r[i] = __builtin_nontemporal_load((const f32x4*)(ti.src + (size_t)(k + i) * ti.N + n));
        else r[i] = (f32x4){0.f, 0.f, 0.f, 0.f};
    }
}
__device__ void phase_convert(const Params& p, unsigned char* lds_raw) {
    const int tid = opaque_tid();
    constexpr int NT_TOTAL = 2 * CONV_TILES_LAYER;
    f32x4 r[16], rn[16];
    int t = blockIdx.x; asm volatile("" : "+s"(t));
    if (t < NT_TOTAL) { TileInfo t0; conv_decode(p, NT_TOTAL - 1 - t, t0); conv_load(t0, r, tid); }
    for (; t < NT_TOTAL; t += gridDim.x) {
        const int tn = t + gridDim.x;
        if (tn < NT_TOTAL) { TileInfo tin; conv_decode(p, NT_TOTAL - 1 - tn, tin); conv_load(tin, rn, tid); }
        {
            TileInfo ti; conv_decode(p, NT_TOTAL - 1 - t, ti);
            const int lane = tid & 63, wave = tid >> 6, n = ti.n0 + (lane & 15) * 4, k = ti.k0 + wave * 64 + (lane >> 4) * 16;
            if (n < ti.N) {
#pragma unroll
                for (int j = 0; j < 4; ++j) {
                    u32x4 w0, w1;
                    w0.x = cvt_pk_bf16(r[0][j], r[1][j]);  w0.y = cvt_pk_bf16(r[2][j], r[3][j]);   w0.z = cvt_pk_bf16(r[4][j], r[5][j]);   w0.w = cvt_pk_bf16(r[6][j], r[7][j]);
                    w1.x = cvt_pk_bf16(r[8][j], r[9][j]);  w1.y = cvt_pk_bf16(r[10][j], r[11][j]); w1.z = cvt_pk_bf16(r[12][j], r[13][j]); w1.w = cvt_pk_bf16(r[14][j], r[15][j]);
                    const int nn = n + j;
                    int row = nn;
                    if (ti.mode == 1) row = (nn >> 7) * 256 + (nn & 127);
                    else if (ti.mode == 2) row = (nn >> 7) * 256 + 128 + (nn & 127);
                    bf16_t* dp = ti.dst + (size_t)row * (ti.K + 64) + k;
                    *(u32x4*)dp = w0; *(u32x4*)(dp + 8) = w1;
                }
            }
        }
#pragma unroll
        for (int i = 0; i < 16; ++i) r[i] = rn[i];
    }
    for (int layer = 0; layer < 2; ++layer) {
        u32x4* z = (u32x4*)(p.ws + (size_t)layer * SZ_LAYERW + OFF_WIN + (size_t)N_IN * H_LD * 2);
        const int n16 = (N_IN_PAD - N_IN) * H_LD * 2 / 16;
        for (int i = blockIdx.x * NTHREADS + tid; i < n16; i += gridDim.x * NTHREADS) z[i] = (u32x4){0u, 0u, 0u, 0u};
    }
}

template <int MODE>
__device__ __forceinline__ void norm_row(const Params& p, const f32x4 (&g)[8], int r, int lane, int nparts, float pscale) {
    float* X = (float*)(p.ws + WS_X); bf16_t* H = (bf16_t*)(p.ws + WS_H);
    const float* src = (MODE == 0) ? (r < 8192 ? inp(p, 0) + (size_t)r * 2048 : inp(p, 1) + (size_t)(r - 8192) * 2048) : X + (size_t)r * 2048;
    f32x4 v[8]; float ss = 0.f;
#pragma unroll
    for (int i = 0; i < 8; ++i) v[i] = *(const f32x4*)(src + i * 256 + lane * 4);
    if (MODE != 0 && nparts > 0 && r >= 8192) {
        const float* pp = (const float*)(p.ws + WS_ST) + (size_t)(r - 8192) * 2048 + lane * 4;
        f32x4 a[8];
#pragma unroll
        for (int i = 0; i < 8; ++i) a[i] = (f32x4){0.f, 0.f, 0.f, 0.f};
        for (int k = 0; k < nparts; ++k) {
#pragma unroll
            for (int i = 0; i < 8; ++i) a[i] += *(const f32x4*)(pp + (size_t)k * (512 * 2048) + i * 256);
        }
#pragma unroll
        for (int i = 0; i < 8; ++i) { v[i] += pscale * a[i]; *(f32x4*)(X + (size_t)r * 2048 + i * 256 + lane * 4) = v[i]; }
    }
#pragma unroll
    for (int i = 0; i < 8; ++i) ss += v[i][0] * v[i][0] + v[i][1] * v[i][1] + v[i][2] * v[i][2] + v[i][3] * v[i][3];
#pragma unroll
    for (int o = 32; o >= 1; o >>= 1) ss += __shfl_xor(ss, o);
    const float rstd = rsqrtf(ss * (1.f / 2048.f) + EPS);
#pragma unroll
    for (int i = 0; i < 8; ++i) {
        if (MODE == 0) *(f32x4*)(X + (size_t)r * 2048 + i * 256 + lane * 4) = v[i];
        const f32x4 o = v[i] * rstd * g[i];
        if (MODE < 2) { u32x2 w; w.x = cvt_pk_bf16(o[0], o[1]); w.y = cvt_pk_bf16(o[2], o[3]); *(u32x2*)(H + (size_t)r * H_LD + i * 256 + lane * 4) = w; }
        else *(f32x4*)(p.out + (size_t)r * 2048 + i * 256 + lane * 4) = o;
    }
}
template <int MODE>
__device__ void phase_norm(const Params& p, const float* gamma, int nparts, float pscale) {
    const int tid = opaque_tid(), lane = tid & 63, wave = tid >> 6;
    f32x4 g[8];
#pragma unroll
    for (int i = 0; i < 8; ++i) g[i] = *(const f32x4*)(gamma + i * 256 + lane * 4);
    if (wave < 2) for (int s = blockIdx.x * 2 + wave; s < 512; s += gridDim.x * 2) norm_row<MODE>(p, g, 8192 + s, lane, nparts, pscale);
    for (int r = blockIdx.x * 8 + wave; r < 8192; r += gridDim.x * 8) norm_row<MODE>(p, g, r, lane, nparts, pscale);
}

__device__ __forceinline__ u32x4 fetch_xbc8(const bf16_t* proj, const float* hist, int c, int lrow, int col) {
    if (lrow >= 0 || (c > 0 && c < NPCH)) return *(const u32x4*)(proj + (size_t)(c * 64 + lrow) * PROJ_LD + 5120 + col);
    if (c == 0) return (u32x4){0u, 0u, 0u, 0u};
    const float* h = hist + ((size_t)(c - NPCH) * 3 + (3 + lrow)) * 4096 + col;
    const f32x4 a = *(const f32x4*)h, b = *(const f32x4*)(h + 4);
    u32x4 w; w.x = cvt_pk_bf16(a[0], a[1]); w.y = cvt_pk_bf16(a[2], a[3]); w.z = cvt_pk_bf16(b[0], b[1]); w.w = cvt_pk_bf16(b[2], b[3]);
    return w;
}
__device__ __forceinline__ void dt_acum(const Params& p, int layer, int c, int h, int lane, float& dtv, float& acum, float& total) {
    const float* DT = (const float*)(p.ws + WS_DT);
    const float raw = DT[(size_t)(c * 64 + lane) * 32 + h];
    dtv = softplus_f(raw + inp(p, 14)[layer * 32 + h]);
    const float A = -expf(inp(p, 15)[layer * 32 + h]);
    float a = dtv * A;
#pragma unroll
    for (int o = 1; o < 64; o <<= 1) { const float t = __shfl_up(a, o); if (lane >= o) a += t; }
    acum = a; total = __shfl(a, 63);
}

__device__ void phase_s1(const Params& p, int layer, unsigned char* lds) {
    bf16_t* s_xwT = (bf16_t*)lds;
    bf16_t* s_BT = (bf16_t*)(lds + 36864);
    float* s_w = (float*)(lds + 55296);
    const int tid = opaque_tid(), lane = tid & 63, wave = tid >> 6, fr = lane & 15, fq = lane >> 4;
    const bf16_t* proj = (const bf16_t*)(p.ws + WS_PROJ);
    bf16_t* mix = (bf16_t*)(p.ws + WS_MIX);
    bf16_t* ST = (bf16_t*)(p.ws + WS_ST);
    float* DEC = (float*)(p.ws + WS_DEC);
    const float* hist = inp(p, 3) + (size_t)layer * 8 * 3 * 4096;
    for (int unit = blockIdx.x; unit < NCHUNK * 8; unit += gridDim.x) {
        const int c = unit >> 3, g = unit & 7, row0 = c * 64;
        const bool last_chunk = (c >= NPCH - 1);
        if (wave < 4) {
            const int h = g * 4 + wave; float dtv, acum, total;
            dt_acum(p, layer, c, h, lane, dtv, acum, total);
            s_w[wave * 64 + lane] = dtv * __expf(total - acum);
            if (lane == 0) DEC[c * 32 + h] = __expf(total);
        }
        __syncthreads();
        if (tid < 384) {
            const int rr = tid & 7, cg = tid >> 3, l0 = rr * 8;
            const int col = (cg < 32) ? g * 256 + cg * 8 : 2048 + g * 128 + (cg - 32) * 8;
            u32x4 rows[11];
#pragma unroll
            for (int i = 0; i < 11; ++i) rows[i] = fetch_xbc8(proj, hist, c, l0 - 3 + i, col);
            const float* cw = inp(p, 12) + (size_t)layer * 4 * 4096 + col; const float* cb = inp(p, 13) + (size_t)layer * 4096 + col;
            float w[4][8], b[8];
#pragma unroll
            for (int k = 0; k < 4; ++k) { const f32x4 a = *(const f32x4*)(cw + k * 4096), bb = *(const f32x4*)(cw + k * 4096 + 4);
#pragma unroll
                for (int j = 0; j < 4; ++j) { w[k][j] = a[j]; w[k][4 + j] = bb[j]; } }
            { const f32x4 a = *(const f32x4*)cb, bb = *(const f32x4*)(cb + 4);
#pragma unroll
              for (int j = 0; j < 4; ++j) { b[j] = a[j]; b[4 + j] = bb[j]; } }
            float sc[8];
#pragma unroll
            for (int i = 0; i < 8; ++i) sc[i] = (cg < 32) ? s_w[(cg >> 3) * 64 + l0 + i] : 1.f;
            bf16_t* dstT = (cg < 32) ? s_xwT + (cg * 8) * 72 + l0 : s_BT + ((cg - 32) * 8) * 72 + l0;
#pragma unroll
            for (int j = 0; j < 8; ++j) {
                float o[8];
#pragma unroll
                for (int i = 0; i < 8; ++i) {
                    float v = b[j];
#pragma unroll
                    for (int k = 0; k < 4; ++k) v += w[k][j] * bfv(rows[i + k], j);
                    o[i] = silu_f(v) * sc[i];
                }
                u32x4 pk; pk.x = cvt_pk_bf16(o[0], o[1]); pk.y = cvt_pk_bf16(o[2], o[3]); pk.z = cvt_pk_bf16(o[4], o[5]); pk.w = cvt_pk_bf16(o[6], o[7]);
                *(u32x4*)(dstT + j * 72) = pk;
            }
        } else {
            const int t2 = tid - 384, rr = t2 & 7, cgi = t2 >> 3, l0 = rr * 8, ch0 = g * 128 + cgi * 8;
            const float* scw = inp(p, 11) + (size_t)layer * 3 * 1024 + ch0;
            float w[3][8];
#pragma unroll
            for (int k = 0; k < 3; ++k) { const f32x4 a = *(const f32x4*)(scw + k * 1024), bb = *(const f32x4*)(scw + k * 1024 + 4);
#pragma unroll
                for (int j = 0; j < 4; ++j) { w[k][j] = a[j]; w[k][4 + j] = bb[j]; } }
            float um2[8], um1[8], u0[8];
#pragma unroll
            for (int i = 0; i < 10; ++i) {
                const int lrow = l0 - 2 + i;
#pragma unroll
                for (int j = 0; j < 8; ++j) { um2[j] = um1[j]; um1[j] = u0[j]; }
                if (lrow >= 0 || (c > 0 && c < NPCH)) {
                    const bf16_t* rp = proj + (size_t)(row0 + lrow) * PROJ_LD + ch0;
                    const u32x4 cv = *(const u32x4*)(rp + 1024), xv = *(const u32x4*)(rp + 2048);
#pragma unroll
                    for (int j = 0; j < 8; ++j) u0[j] = bfv(cv, j) * bfv(xv, j);
                } else if (c == 0) {
#pragma unroll
                    for (int j = 0; j < 8; ++j) u0[j] = 0.f;
                } else {
                    const float* hp = inp(p, 2) + (((size_t)layer * 8 + (c - NPCH)) * 2 + (2 + lrow)) * 1024 + ch0;
                    const f32x4 a = *(const f32x4*)hp, bb = *(const f32x4*)(hp + 4);
#pragma unroll
                    for (int j = 0; j < 4; ++j) { u0[j] = a[j]; u0[4 + j] = bb[j]; }
                }
                if (i >= 2) {
                    const int l = l0 + i - 2;
                    const u32x4 bv = *(const u32x4*)(proj + (size_t)(row0 + l) * PROJ_LD + ch0);
                    float y[8];
#pragma unroll
                    for (int j = 0; j < 8; ++j) y[j] = bfv(bv, j) * (w[0][j] * um2[j] + w[1][j] * um1[j] + w[2][j] * u0[j]);
                    u32x4 pk; pk.x = cvt_pk_bf16(y[0], y[1]); pk.y = cvt_pk_bf16(y[2], y[3]); pk.z = cvt_pk_bf16(y[4], y[5]); pk.w = cvt_pk_bf16(y[6], y[7]);
                    *(u32x4*)(mix + (size_t)(row0 + l) * MIX_LD + ch0) = pk;
                    if (last_chunk && l >= 62) {
                        float* op = (c < NPCH) ? p.out + O_SC_P + ((size_t)layer * 2 + (l - 62)) * 1024 + ch0
                                               : p.out + O_SC_S + (((size_t)layer * 8 + (c - NPCH)) * 2 + (l - 62)) * 1024 + ch0;
                        *(f32x4*)op = (f32x4){u0[0], u0[1], u0[2], u0[3]}; *(f32x4*)(op + 4) = (f32x4){u0[4], u0[5], u0[6], u0[7]};
                    }
                }
            }
        }
        __syncthreads();
        {
            const int hh = wave >> 1, half = wave & 1, h = g * 4 + hh;
            f32x4 acc[4][4];
#pragma unroll
            for (int a = 0; a < 4; ++a)
#pragma unroll
                for (int b = 0; b < 4; ++b) acc[a][b] = (f32x4){0.f, 0.f, 0.f, 0.f};
#pragma unroll
            for (int ks = 0; ks < 2; ++ks) {
                bf16x8 af[4], bfr[4];
#pragma unroll
                for (int a = 0; a < 4; ++a) af[a] = *(const bf16x8*)(s_BT + (half * 64 + a * 16 + fr) * 72 + ks * 32 + fq * 8);
#pragma unroll
                for (int b = 0; b < 4; ++b) bfr[b] = *(const bf16x8*)(s_xwT + (hh * 64 + b * 16 + fr) * 72 + ks * 32 + fq * 8);
#pragma unroll
                for (int a = 0; a < 4; ++a)
#pragma unroll
                    for (int b = 0; b < 4; ++b) acc[a][b] = __builtin_amdgcn_mfma_f32_16x16x32_bf16(af[a], bfr[b], acc[a][b], 0, 0, 0);
            }
            bf16_t* stp = ST + ((size_t)(c * 32 + h) * 64) * 128;
#pragma unroll
            for (int a = 0; a < 4; ++a)
#pragma unroll
                for (int b = 0; b < 4; ++b) {
                    u32x2 w; w.x = cvt_pk_bf16(acc[a][b][0], acc[a][b][1]); w.y = cvt_pk_bf16(acc[a][b][2], acc[a][b][3]);
                    *(u32x2*)(stp + (size_t)(b * 16 + fr) * 128 + half * 64 + a * 16 + fq * 4) = w;
                }
        }
        __syncthreads();
    }
}

__device__ void phase_s2(const Params& p, int layer) {
    unsigned* ST32 = (unsigned*)(p.ws + WS_ST);
    const float* DEC = (const float*)(p.ws + WS_DEC);
    constexpr int NP = 32 * 64 * 128 / 2;
    const int gtid = blockIdx.x * NTHREADS + opaque_tid(), nth = gridDim.x * NTHREADS;
    for (int idx = gtid; idx < NP; idx += nth) {
        const int h = idx >> 12;
        float s0 = 0.f, s1 = 0.f;
        for (int c0 = 0; c0 < NPCH; c0 += 16) {
            unsigned v[16]; float d[16];
#pragma unroll
            for (int j = 0; j < 16; ++j) { v[j] = ST32[(size_t)(c0 + j) * NP + idx]; d[j] = DEC[(c0 + j) * 32 + h]; }
#pragma unroll
            for (int j = 0; j < 16; ++j) {
                ST32[(size_t)(c0 + j) * NP + idx] = cvt_pk_bf16(s0, s1);
                s0 = s0 * d[j] + bf_lo(v[j]); s1 = s1 * d[j] + bf_hi(v[j]);
            }
        }
        *(f32x2*)(p.out + O_SSM_P + (size_t)layer * 262144 + 2 * (size_t)idx) = (f32x2){s0, s1};
    }
    for (int it = gtid; it < 8 * NP; it += nth) {
        const int b = it / NP, idx = it % NP, h = idx >> 12;
        const f32x2 s = *(const f32x2*)(inp(p, 4) + ((size_t)layer * 8 + b) * 262144 + 2 * (size_t)idx);
        const unsigned v = ST32[(size_t)(NPCH + b) * NP + idx];
        const float d = DEC[(NPCH + b) * 32 + h];
        ST32[(size_t)(NPCH + b) * NP + idx] = cvt_pk_bf16(s[0], s[1]);
        *(f32x2*)(p.out + O_SSM_S + ((size_t)layer * 8 + b) * 262144 + 2 * (size_t)idx) = (f32x2){s[0] * d + bf_lo(v), s[1] * d + bf_hi(v)};
    }
}

__device__ void phase_s3(const Params& p, int layer, unsigned char* lds) {
    bf16_t* s_xsT = (bf16_t*)lds;
    bf16_t* s_B = (bf16_t*)(lds + 36864);
    bf16_t* s_C = (bf16_t*)(lds + 36864 + 17408);
    bf16_t* s_M = (bf16_t*)(lds + 71680);
    float* s_dt = (float*)(lds + 108544);
    float* s_acum = s_dt + 256;
    float* s_ssq = s_acum + 256;
    const int tid = opaque_tid(), lane = tid & 63, wave = tid >> 6, fr = lane & 15, fq = lane >> 4;
    const bf16_t* proj = (const bf16_t*)(p.ws + WS_PROJ);
    bf16_t* mix = (bf16_t*)(p.ws + WS_MIX);
    const bf16_t* ST = (const bf16_t*)(p.ws + WS_ST);
    const float* hist = inp(p, 3) + (size_t)layer * 8 * 3 * 4096;
    for (int unit = blockIdx.x; unit < NCHUNK * 8; unit += gridDim.x) {
        const int c = unit >> 3, g = unit & 7, row0 = c * 64;
        const bool last_chunk = (c >= NPCH - 1);
        if (wave < 4) {
            const int h = g * 4 + wave; float dtv, acum, total;
            dt_acum(p, layer, c, h, lane, dtv, acum, total);
            s_dt[wave * 64 + lane] = dtv; s_acum[wave * 64 + lane] = acum;
        }
        {
            const int rr = tid & 7, cg = tid >> 3, l0 = rr * 8;
            const int col = (cg < 32) ? g * 256 + cg * 8 : (cg < 48 ? 2048 + g * 128 + (cg - 32) * 8 : 3072 + g * 128 + (cg - 48) * 8);
            u32x4 rows[11];
#pragma unroll
            for (int i = 0; i < 11; ++i) rows[i] = fetch_xbc8(proj, hist, c, l0 - 3 + i, col);
            const float* cw = inp(p, 12) + (size_t)layer * 4 * 4096 + col; const float* cb = inp(p, 13) + (size_t)layer * 4096 + col;
            float w[4][8], b[8];
#pragma unroll
            for (int k = 0; k < 4; ++k) { const f32x4 a = *(const f32x4*)(cw + k * 4096), bb = *(const f32x4*)(cw + k * 4096 + 4);
#pragma unroll
                for (int j = 0; j < 4; ++j) { w[k][j] = a[j]; w[k][4 + j] = bb[j]; } }
            { const f32x4 a = *(const f32x4*)cb, bb = *(const f32x4*)(cb + 4);
#pragma unroll
              for (int j = 0; j < 4; ++j) { b[j] = a[j]; b[4 + j] = bb[j]; } }
            if (last_chunk && rr == 7) {
#pragma unroll
                for (int i = 0; i < 3; ++i) {
                    float* op = (c < NPCH) ? p.out + O_CONV_P + ((size_t)layer * 3 + i) * 4096 + col
                                           : p.out + O_CONV_S + (((size_t)layer * 8 + (c - NPCH)) * 3 + i) * 4096 + col;
                    const u32x4 rv = rows[8 + i];
                    *(f32x4*)op = (f32x4){bf_lo(rv.x), bf_hi(rv.x), bf_lo(rv.y), bf_hi(rv.y)}; *(f32x4*)(op + 4) = (f32x4){bf_lo(rv.z), bf_hi(rv.z), bf_lo(rv.w), bf_hi(rv.w)};
                }
            }
            if (cg < 32) {
#pragma unroll
                for (int j = 0; j < 8; ++j) {
                    float o[8];
#pragma unroll
                    for (int i = 0; i < 8; ++i) {
                        float v = b[j];
#pragma unroll
                        for (int k = 0; k < 4; ++k) v += w[k][j] * bfv(rows[i + k], j);
                        o[i] = silu_f(v);
                    }
                    u32x4 pk; pk.x = cvt_pk_bf16(o[0], o[1]); pk.y = cvt_pk_bf16(o[2], o[3]); pk.z = cvt_pk_bf16(o[4], o[5]); pk.w = cvt_pk_bf16(o[6], o[7]);
                    *(u32x4*)(s_xsT + (cg * 8 + j) * 72 + l0) = pk;
                }
            } else {
                bf16_t* dst = (cg < 48) ? s_B + (cg - 32) * 8 : s_C + (cg - 48) * 8;
#pragma unroll
                for (int i = 0; i < 8; ++i) {
                    float o[8];
#pragma unroll
                    for (int j = 0; j < 8; ++j) {
                        float v = b[j];
#pragma unroll
                        for (int k = 0; k < 4; ++k) v += w[k][j] * bfv(rows[i + k], j);
                        o[j] = silu_f(v);
                    }
                    u32x4 pk; pk.x = cvt_pk_bf16(o[0], o[1]); pk.y = cvt_pk_bf16(o[2], o[3]); pk.z = cvt_pk_bf16(o[4], o[5]); pk.w = cvt_pk_bf16(o[6], o[7]);
                    *(u32x4*)(dst + (l0 + i) * 136) = pk;
                }
            }
        }
        __syncthreads();
        const int hh_y = wave >> 1, half_y = wave & 1, h_y = g * 4 + hh_y;
        u32x2 zv[2][4];
#pragma unroll
        for (int lti = 0; lti < 2; ++lti)
#pragma unroll
            for (int pt = 0; pt < 4; ++pt) zv[lti][pt] = *(const u32x2*)(proj + (size_t)(row0 + (2 * half_y + lti) * 16 + fr) * PROJ_LD + 3072 + h_y * 64 + pt * 16 + fq * 4);
        bf16x8 aPall[4][4];
        {
            const bf16_t* prev = ST + ((size_t)(c * 32 + h_y) * 64) * 128;
#pragma unroll
            for (int ks = 0; ks < 4; ++ks)
#pragma unroll
                for (int pt = 0; pt < 4; ++pt) aPall[ks][pt] = *(const bf16x8*)(prev + (size_t)(pt * 16 + fr) * 128 + ks * 32 + fq * 8);
        }
        {
            const int lt = wave >> 1;
#pragma unroll
            for (int sti = 0; sti < 2; ++sti) {
                const int st = (wave & 1) * 2 + sti;
                f32x4 acc = (f32x4){0.f, 0.f, 0.f, 0.f};
                if (st <= lt) {
#pragma unroll
                    for (int ks = 0; ks < 4; ++ks) {
                        const bf16x8 a = *(const bf16x8*)(s_C + (lt * 16 + fr) * 136 + ks * 32 + fq * 8);
                        const bf16x8 b = *(const bf16x8*)(s_B + (st * 16 + fr) * 136 + ks * 32 + fq * 8);
                        acc = __builtin_amdgcn_mfma_f32_16x16x32_bf16(a, b, acc, 0, 0, 0);
                    }
                }
                const int s = st * 16 + fr;
                if (st > lt) {
#pragma unroll
                    for (int hh = 0; hh < 4; ++hh)
#pragma unroll
                        for (int r = 0; r < 4; ++r) s_M[(hh * 64 + lt * 16 + fq * 4 + r) * 72 + s] = (bf16_t)0;
                } else {
#pragma unroll
                    for (int hh = 0; hh < 4; ++hh) {
                        const float as = s_acum[hh * 64 + s], ds = s_dt[hh * 64 + s], Dh = inp(p, 16)[layer * 32 + g * 4 + hh];
#pragma unroll
                        for (int r = 0; r < 4; ++r) {
                            const int l = lt * 16 + fq * 4 + r;
                            float v = 0.f;
                            if (s <= l) v = acc[r] * __expf(s_acum[hh * 64 + l] - as) * ds;
                            if (s == l) v += Dh;
                            s_M[(hh * 64 + l) * 72 + s] = (bf16_t)(cvt_pk_bf16(v, 0.f) & 0xffffu);
                        }
                    }
                }
            }
        }
        __syncthreads();
        {
            const int hh = wave >> 1, half = wave & 1, h = g * 4 + hh;
            f32x4 acc1[2][4], acc2[2][4];
#pragma unroll
            for (int a = 0; a < 2; ++a)
#pragma unroll
                for (int b = 0; b < 4; ++b) { acc1[a][b] = (f32x4){0.f, 0.f, 0.f, 0.f}; acc2[a][b] = (f32x4){0.f, 0.f, 0.f, 0.f}; }
#pragma unroll
            for (int ks = 0; ks < 4; ++ks) {
                bf16x8 bC[2];
#pragma unroll
                for (int lti = 0; lti < 2; ++lti) bC[lti] = *(const bf16x8*)(s_C + ((2 * half + lti) * 16 + fr) * 136 + ks * 32 + fq * 8);
#pragma unroll
                for (int lti = 0; lti < 2; ++lti)
#pragma unroll
                    for (int pt = 0; pt < 4; ++pt) acc2[lti][pt] = __builtin_amdgcn_mfma_f32_16x16x32_bf16(aPall[ks][pt], bC[lti], acc2[lti][pt], 0, 0, 0);
            }
#pragma unroll
            for (int ks = 0; ks < 2; ++ks) {
                if (ks == 1 && half == 0) continue;
                bf16x8 bM[2], aX[4];
#pragma unroll
                for (int lti = 0; lti < 2; ++lti) bM[lti] = *(const bf16x8*)(s_M + (hh * 64 + (2 * half + lti) * 16 + fr) * 72 + ks * 32 + fq * 8);
#pragma unroll
                for (int pt = 0; pt < 4; ++pt) aX[pt] = *(const bf16x8*)(s_xsT + (hh * 64 + pt * 16 + fr) * 72 + ks * 32 + fq * 8);
#pragma unroll
                for (int lti = 0; lti < 2; ++lti)
#pragma unroll
                    for (int pt = 0; pt < 4; ++pt) acc1[lti][pt] = __builtin_amdgcn_mfma_f32_16x16x32_bf16(aX[pt], bM[lti], acc1[lti][pt], 0, 0, 0);
            }
#pragma unroll
            for (int lti = 0; lti < 2; ++lti) {
                const int l = (2 * half + lti) * 16 + fr;
                const float e = __expf(s_acum[hh * 64 + l]);
                float ss = 0.f;
#pragma unroll
                for (int pt = 0; pt < 4; ++pt) {
                    const float z0 = bf_lo(zv[lti][pt].x), z1 = bf_hi(zv[lti][pt].x), z2 = bf_lo(zv[lti][pt].y), z3 = bf_hi(zv[lti][pt].y);
                    f32x4 u = acc1[lti][pt] + e * acc2[lti][pt];
                    u[0] *= silu_f(z0); u[1] *= silu_f(z1); u[2] *= silu_f(z2); u[3] *= silu_f(z3);
                    acc1[lti][pt] = u;
                    ss += u[0] * u[0] + u[1] * u[1] + u[2] * u[2] + u[3] * u[3];
                }
                ss += __shfl_xor(ss, 16); ss += __shfl_xor(ss, 32);
                if (fq == 0) s_ssq[hh * 64 + l] = ss;
            }
            __syncthreads();
            const float* nw = inp(p, 17) + (size_t)layer * 2048 + h * 64;
#pragma unroll
            for (int lti = 0; lti < 2; ++lti) {
                const int l = (2 * half + lti) * 16 + fr;
                const float scale = rsqrtf(((s_ssq[l] + s_ssq[64 + l]) + (s_ssq[128 + l] + s_ssq[192 + l])) * (1.f / 256.f) + EPS);
#pragma unroll
                for (int pt = 0; pt < 4; ++pt) {
                    const f32x4 w4 = *(const f32x4*)(nw + pt * 16 + fq * 4);
                    const f32x4 o = acc1[lti][pt] * scale * w4;
                    u32x2 w; w.x = cvt_pk_bf16(o[0], o[1]); w.y = cvt_pk_bf16(o[2], o[3]);
                    *(u32x2*)(mix + (size_t)(row0 + l) * MIX_LD + 1024 + h * 64 + pt * 16 + fq * 4) = w;
                }
            }
        }
        __syncthreads();
    }
}

#define XB_TMO      128
#define XB_XCNT(j)  (256  + 64 * (j))
#define XB_XSUB(j)  (1280 + 64 * (j))
#define XB_XGEN(j)  (2304 + 64 * (j))
#define XB_TOP      3328
#define XB_TOPGEN   3392
#define XCD_BAR_WORDS 3456
#define XB_SPIN_CAP (1u << 18)

__device__ __forceinline__ unsigned xb_ld(unsigned* p)              { return __hip_atomic_load(p, __ATOMIC_RELAXED, __HIP_MEMORY_SCOPE_AGENT); }
__device__ __forceinline__ unsigned xb_add(unsigned* p, unsigned v) { return __hip_atomic_fetch_add(p, v, __ATOMIC_RELAXED, __HIP_MEMORY_SCOPE_AGENT); }
__device__ __forceinline__ unsigned xb_xcc_id() { return (unsigned)__builtin_amdgcn_s_getreg((3 << 11) | 20) & 0xFu; }
#define XB_SPIN(cond, bar) do { unsigned _sp = 0; while (cond) { __builtin_amdgcn_s_sleep(1); \
    if ((++_sp & 255u) == 0u) { if (xb_ld(&(bar)[XB_TMO])) break; if (_sp > XB_SPIN_CAP) { atomicAdd(&(bar)[XB_TMO], 1u); break; } } } } while (0)

struct XcdBarrier {
    unsigned* bar; unsigned x;
    volatile LAS unsigned* st;
};

__device__ __forceinline__ XcdBarrier xcd_barrier_post(unsigned* bar, volatile LAS unsigned* st) {
    XcdBarrier b; b.bar = bar; b.x = xb_xcc_id(); b.st = st;
    if (threadIdx.x == 0) (void)xb_add(&bar[XB_XCNT(b.x)], 1u);
    return b;
}
__device__ __forceinline__ void xcd_barrier_complete(unsigned* bar, unsigned x, unsigned& nloc, unsigned& nx) {
    const unsigned G = gridDim.x * gridDim.y * gridDim.z;
    unsigned sum, cnt, mine, sp = 0u;
    for (;;) {
        sum = 0u; cnt = 0u; mine = 0u;
#pragma unroll
        for (unsigned j = 0; j < 16; ++j) { const unsigned c = xb_ld(&bar[XB_XCNT(j)]); sum += c; cnt += (c > 0u) ? 1u : 0u; mine = (j == x) ? c : mine; }
        if (sum == G) break;
        __builtin_amdgcn_s_sleep(1);
        if ((++sp & 255u) == 0u) { if (xb_ld(&bar[XB_TMO])) break; if (sp > XB_SPIN_CAP) { atomicAdd(&bar[XB_TMO], 1u); break; } }
    }
    nloc = mine > 0u ? mine : 1u; nx = cnt > 0u ? cnt : 1u;
}

__device__ __forceinline__ void xcd_barrier(const XcdBarrier& b) {
    asm volatile("s_waitcnt vmcnt(0)" ::: "memory");
    __syncthreads();
    if (threadIdx.x == 0) {
        unsigned* bar = b.bar;
        __builtin_amdgcn_s_waitcnt(0);
        unsigned nloc = b.st[0], nx = b.st[1];
        if (nloc == 0u) { xcd_barrier_complete(bar, b.x, nloc, nx); b.st[0] = nloc; b.st[1] = nx; }
        const unsigned old = xb_add(&bar[XB_XSUB(b.x)], 1u);
        const unsigned gen = old / nloc;
        if (old + 1u == (gen + 1u) * nloc) {
            __builtin_amdgcn_fence(__ATOMIC_RELEASE, "agent");
            asm volatile("s_waitcnt vmcnt(0)" ::: "memory");
            const unsigned og = xb_add(&bar[XB_TOP], 1u);
            const unsigned tg = og / nx;
            if (og + 1u == (tg + 1u) * nx) xb_add(&bar[XB_TOPGEN], 1u);
            else XB_SPIN(xb_ld(&bar[XB_TOPGEN]) == tg, bar);
            __builtin_amdgcn_fence(__ATOMIC_ACQUIRE, "agent");
            xb_add(&bar[XB_XGEN(b.x)], 1u);
            asm volatile("s_waitcnt vmcnt(0)" ::: "memory");
        } else {
            XB_SPIN(xb_ld(&bar[XB_XGEN(b.x)]) == gen, bar);
            __builtin_amdgcn_fence(__ATOMIC_ACQUIRE, "agent");
            asm volatile("s_waitcnt vmcnt(0)" ::: "memory");
        }
    }
    __syncthreads();
}

#ifndef PROG_LIST
#define PROG_LIST 0,1,2,3,4,5,6,7,8,9,10,11,12,13,14,15,16,17,18,19,20,21,22,23,24
#endif
__constant__ int PROG[] = {PROG_LIST};

__global__ void __launch_bounds__(NTHREADS, 2) fwd_kernel(Params p) {
    extern __shared__ __attribute__((aligned(16))) unsigned char lds_raw[];
    LAS unsigned char* lds = (LAS unsigned char*)lds_raw;
    float* X = (float*)(p.ws + WS_X); bf16_t* H = (bf16_t*)(p.ws + WS_H); bf16_t* ACT = (bf16_t*)(p.ws + WS_PROJ); bf16_t* PROJ = (bf16_t*)(p.ws + WS_PROJ);
    bf16_t* MIX = (bf16_t*)(p.ws + WS_MIX); float* DT = (float*)(p.ws + WS_DT);
    float* PART = (float*)(p.ws + WS_ST);
    const int G = gridDim.x, cblk = blockIdx.x;
    { volatile LAS unsigned* stw = (volatile LAS unsigned*)(lds + 131072); if (threadIdx.x < 4) stw[threadIdx.x] = 0u; }
    __syncthreads();
    const XcdBarrier xbar = xcd_barrier_post((unsigned*)(p.ws + WS_CTL), (volatile LAS unsigned*)(lds + 131072));
    for (int pi = p.ph_lo; pi < p.ph_hi; ++pi) {
        const int ph = PROG[pi];
        if (ph == 0) {
            phase_convert(p, lds_raw);
            phase_norm<0>(p, inp(p, 5), 0, 0.f);
        } else {
            const int layer = (ph - 1) / 12, sub = (ph - 1) % 12;
            unsigned char* wl = p.ws + (size_t)layer * SZ_LAYERW;
            if (sub == 0 || sub == 9) {
                pg8::Gemm g{H, (const bf16_t*)(wl + (sub == 0 ? OFF_WGU1 : OFF_WGU2)), M_ROWS, 11264, H_LD, 2048};
                typedef pg8::SplitOrder<M_ROWS, 11264, 1, 2048> SO; SO S; S.init(G, cblk);
                pg8::EpiSwiglu E{ACT};
                pg8::gemm_phase<pg8::EpiSwiglu, SO, H_LD>(lds, g, S, E);
            } else if (sub == 1 || sub == 10) {
                pg8::Gemm g{ACT, (const bf16_t*)(wl + (sub == 1 ? OFF_WD1 : OFF_WD2)), M_ROWS, 2048, ACT_LD, D_FF};
                typedef pg8::MixedOrder<D_FF, 11> SO; SO S; S.init(G, cblk);
                pg8::EpiAtomic E{X, PART, 0.5f};
                pg8::gemm_phase<pg8::EpiAtomic, SO, ACT_LD>(lds, g, S, E);
            } else if (sub == 7) {
                pg8::Gemm g{MIX, (const bf16_t*)(wl + OFF_WOUT), M_ROWS, 2048, MIX_LD, D_MIX};
                typedef pg8::MixedOrder<D_MIX, 12> SO; SO S; S.init(G, cblk);
                pg8::EpiAtomic E{X, PART, 1.0f};
                pg8::gemm_phase<pg8::EpiAtomic, SO, MIX_LD>(lds, g, S, E);
            } else if (sub == 2 || sub == 8) {
                if (sub == 2) phase_norm<1>(p, inp(p, 9) + (size_t)layer * 2048, 11, 0.5f);
                else phase_norm<1>(p, inp(p, 19) + (size_t)layer * 2048, 12, 1.0f);
            } else if (sub == 3) {
                pg8::Gemm g{H, (const bf16_t*)(wl + OFF_WIN), M_ROWS, N_IN_PAD, H_LD, 2048};
                typedef pg8::SplitOrder<M_ROWS, N_IN_PAD, 1, 2048> SO; SO S; S.init(G, cblk);
                pg8::EpiProj E{PROJ, DT};
                pg8::gemm_phase<pg8::EpiProj, SO, H_LD>(lds, g, S, E);
            } else if (sub == 4) {
                phase_s1(p, layer, lds_raw);
            } else if (sub == 5) {
                phase_s2(p, layer);
            } else if (sub == 6) {
                phase_s3(p, layer, lds_raw);
            } else {
                if (layer == 0) phase_norm<1>(p, inp(p, 5) + 2048, 11, 0.5f);
                else phase_norm<2>(p, inp(p, 23), 11, 0.5f);
            }
        }
        if (pi + 1 < p.ph_hi) {
            if (p.ph_hi > 4096) cg::this_grid().sync();
            xcd_barrier(xbar);
        }
    }
}

#ifndef PROG_LIST
#error
#endif
static const int prog_host[] = {PROG_LIST};
#define NPROG_HOST ((int)(sizeof(prog_host) / sizeof(int)))
extern "C" void kernel_launch(void* const* d_in, const int* in_sizes, int n_in, void* d_out, int out_size, void* d_ws, size_t ws_size, hipStream_t stream) {
    static int grid = 0;
    if (grid == 0) {
        int dev = 0, cus = 0, per_cu = 0;
        hipGetDevice(&dev);
        hipDeviceGetAttribute(&cus, hipDeviceAttributeMultiprocessorCount, dev);
        if (hipFuncSetAttribute((const void*)fwd_kernel, hipFuncAttributeMaxDynamicSharedMemorySize, LDS_BYTES) != hipSuccess) fprintf(stderr, "kernel_launch: hipFuncSetAttribute failed\n");
        if (hipOccupancyMaxActiveBlocksPerMultiprocessor(&per_cu, (const void*)fwd_kernel, NTHREADS, LDS_BYTES) != hipSuccess || per_cu < 1) { fprintf(stderr, "kernel_launch: occupancy query says %d\n", per_cu); per_cu = 1; }
        (void)hipGetLastError();
        if (per_cu > 1) per_cu = 1;
        grid = cus * per_cu;
        if (ws_size < WS_END) fprintf(stderr, "kernel_launch: workspace too small: %zu < %zu\n", ws_size, (size_t)WS_END);
    }
    Params p{};
    for (int i = 0; i < 24; ++i) p.in[i] = (const float*)d_in[i];
    p.out = (float*)d_out; p.ws = (unsigned char*)d_ws;
#if ONE_LAUNCH
    hipMemsetAsync((unsigned char*)d_ws + WS_CTL, 0, 16384, stream);
    p.ph_lo = 0; p.ph_hi = NPROG_HOST;
    void* args[] = {&p};
    hipError_t e = hipLaunchCooperativeKernel((const void*)fwd_kernel, dim3(grid), dim3(NTHREADS), args, LDS_BYTES, stream);
    if (e != hipSuccess) fprintf(stderr, "cooperative launch failed: %s (grid %d)\n", hipGetErrorString(e), grid);
#else
#ifndef PH_LIST
#define PH_LIST 0,1,2,3,4,5,6,7,8,9,10,11,12,13,14,15,16,17,18,19,20,21,22,23,24
#endif
    const int phl[] = {PH_LIST};
    for (int ph : phl) {
        p.ph_lo = ph; p.ph_hi = ph + 1;
        hipLaunchKernelGGL(fwd_kernel, dim3(grid), dim3(NTHREADS), LDS_BYTES, stream, p);
    }
#endif
}
```

```cpp
#include <hip/hip_runtime.h>
#include <hip/hip_cooperative_groups.h>
#include <cstdio>
namespace cg = cooperative_groups;

#ifndef ONE_LAUNCH
#define ONE_LAUNCH 1
#endif

#define LAS __attribute__((address_space(3)))
typedef unsigned short bf16_t;
typedef short bf16x8 __attribute__((ext_vector_type(8)));
typedef float f32x4 __attribute__((ext_vector_type(4)));
typedef float f32x2 __attribute__((ext_vector_type(2)));
typedef unsigned u32x4 __attribute__((ext_vector_type(4)));
typedef unsigned u32x2 __attribute__((ext_vector_type(2)));

constexpr int D_MODEL = 2048, M_ROWS = 8704, NCHUNK = 136, NPCH = 128;
constexpr int D_FF = 5632, PROJ_LD = 9216, N_IN = 9248, N_IN_PAD = 9472, D_MIX = 3072;
constexpr int H_LD = 2048, ACT_LD = D_FF, MIX_LD = D_MIX;
constexpr float EPS = 1e-6f;
constexpr int NTHREADS = 512;
constexpr int LDS_BYTES = 131072 + 16;

constexpr size_t O_SC_P = 17825792, O_CONV_P = 17829888, O_SSM_P = 17854464, O_SC_S = 18378752, O_CONV_S = 18411520, O_SSM_S = 18608128;

constexpr size_t SZ_WGU = (size_t)11264 * H_LD * 2, SZ_WD = (size_t)2048 * ACT_LD * 2, SZ_WIN = (size_t)N_IN_PAD * H_LD * 2, SZ_WOUT = (size_t)2048 * MIX_LD * 2;
constexpr size_t OFF_WGU1 = 0, OFF_WD1 = SZ_WGU, OFF_WIN = SZ_WGU + SZ_WD, OFF_WOUT = OFF_WIN + SZ_WIN, OFF_WGU2 = OFF_WOUT + SZ_WOUT, OFF_WD2 = OFF_WGU2 + SZ_WGU;
constexpr size_t SZ_LAYERW = 2 * SZ_WGU + 2 * SZ_WD + SZ_WIN + SZ_WOUT;
constexpr size_t WS_X = 2 * SZ_LAYERW;
constexpr size_t WS_H = WS_X + (size_t)M_ROWS * 2048 * 4;
constexpr size_t WS_PROJ = WS_H + (size_t)M_ROWS * H_LD * 2;
constexpr size_t WS_MIX = WS_PROJ + (size_t)M_ROWS * PROJ_LD * 2;
constexpr size_t WS_ST = WS_MIX + (size_t)M_ROWS * MIX_LD * 2;
constexpr size_t WS_DT = WS_ST + (size_t)NCHUNK * 32 * 64 * 128 * 2;
constexpr size_t WS_DEC = WS_DT + (size_t)M_ROWS * 32 * 4;
constexpr size_t WS_CTL = WS_DEC + (size_t)NCHUNK * 32 * 4;
constexpr size_t WS_END = WS_CTL + 16384;

struct Params { const float* in[24]; float* out; unsigned char* ws; int ph_lo, ph_hi; };

__device__ __forceinline__ const float* inp(const Params& p, int i) { asm volatile("" : "+s"(i)); return p.in[i]; }
__device__ __forceinline__ float bf_lo(unsigned u) { return __uint_as_float(u << 16); }
__device__ __forceinline__ float bf_hi(unsigned u) { return __uint_as_float(u & 0xffff0000u); }
typedef __bf16 bf16x2v __attribute__((ext_vector_type(2)));
__device__ __forceinline__ unsigned cvt_pk_bf16(float lo, float hi) { f32x2 v = {lo, hi}; bf16x2v b = __builtin_convertvector(v, bf16x2v); return __builtin_bit_cast(unsigned, b); }
__device__ __forceinline__ float silu_f(float x) { return x * __builtin_amdgcn_rcpf(1.f + __expf(-x)); }
__device__ __forceinline__ float softplus_f(float x) { return x > 20.f ? x : log1pf(expf(x)); }
__device__ __forceinline__ int opaque_tid() { int t = threadIdx.x; asm volatile("" : "+v"(t)); return t; }
__device__ __forceinline__ float bfv(const u32x4& v, int j) { const unsigned w = v[j >> 1]; return (j & 1) ? bf_hi(w) : bf_lo(w); }

namespace pg8 {
constexpr int BM = 256, BK = 64, HALF = 128, HTB = HALF * BK * 2, STAGE_BYTES = 8 * HTB, NXCD = 8, WGM = 8;
__host__ __device__ __forceinline__ int lds_byte(int r, int c) { const int st = (r >> 4) * 2 + (c >> 5), rr = r & 15, cc = c & 31, ob = rr * 64 + cc * 2; return st * 1024 + (ob ^ (((ob >> 9) & 1) << 5)); }
__host__ __device__ __forceinline__ void stage_rc(int b, int& R, int& C) { const int st = b / 1024, sb = b % 1024, swz = sb ^ (((sb >> 9) & 1) << 5); R = (st >> 1) * 16 + swz / 64; C = (st & 1) * 32 + (swz % 64) / 2; }
__host__ __device__ __forceinline__ int perm32(int rho) { const int n = rho >> 4, i = rho & 15; return 8 * (i >> 2) + 4 * n + (i & 3); }

__host__ __device__ __forceinline__ int perm32_inv(int s) { return 16 * ((s >> 2) & 1) + 4 * (s >> 3) + (s & 3); }
__device__ __forceinline__ size_t img_off(int row, int col, int KT) {
    return ((size_t)((row >> 8) * KT + (col >> 6)) << 14) + (size_t)(((row >> 7) & 1) << 13) + (size_t)(lds_byte(row & 127, col & 63) >> 1);
}
struct Unit { int pm, pn, kofs, nt, part; };
struct Gemm { const bf16_t* A; const bf16_t* Bt; int M, N, ld, Kc; };

template <int M, int N, int KS, int Kc>
struct SplitOrder {
    static constexpr int nM = M / BM, nN = N / BM, nwg = nM * nN;
    int G, c;
    __device__ void init(int G_, int c_) { G = G_; c = c_; }
    __device__ bool next(int i, Unit& u) const {
        const int L = i * G + c; if (L >= nwg * KS) return false;
        const int ks = L / nwg; int wgid = L - ks * nwg;
        { const int q = nwg / NXCD, r = nwg % NXCD, xcd = wgid % NXCD, off = wgid / NXCD; wgid = (xcd < r ? xcd * (q + 1) : r * (q + 1) + (xcd - r) * q) + off; }
        const int nig = WGM * nN, gid = wgid / nig, fm = gid * WGM, gsz = (nM - fm) < WGM ? (nM - fm) : WGM;
        u.pm = fm + ((wgid % nig) % gsz); u.pn = (wgid % nig) / gsz; u.kofs = ks * Kc; u.nt = Kc / BK; u.part = -1; return true;
    }
};


template <int K, int KS>
struct MixedOrder {
    static constexpr int nFull = 256, KcP = K / KS;
    int G, c;
    __device__ void init(int G_, int c_) { G = G_; c = c_; }
    __device__ bool next(int i, Unit& u) const {
        const int L = i * G + c;
        if (L < nFull) {
            int wgid = L; { const int q = nFull / NXCD, xcd = wgid % NXCD, off = wgid / NXCD; wgid = xcd * q + off; }
            const int nig = WGM * 8, gid = wgid / nig, fm = gid * WGM;
            u.pm = fm + ((wgid % nig) % WGM); u.pn = (wgid % nig) / WGM; u.kofs = 0; u.nt = K / BK; u.part = -1; return true;
        }
        const int q = L - nFull; if (q >= 16 * KS) return false;
        const int tile = q / KS, ks = q - tile * KS;
        u.pm = 32 + (tile >> 3); u.pn = tile & 7; u.kofs = ks * KcP; u.nt = KcP / BK; u.part = ks; return true;
    }
};

struct EpiSwiglu {
    static constexpr bool PERM = true;
    bf16_t* O;
    __device__ __forceinline__ void operator()(const f32x4 (&acc)[2][2][4][2], const Unit& u, int wr, int wc, int fr, int fq) const {
        const int row0 = u.pm * BM + wr * 64 + fr, col0 = u.pn * 128 + wc * 32 + 8 * fq;
#pragma unroll
        for (int ai = 0; ai < 2; ++ai)
#pragma unroll
            for (int m = 0; m < 4; ++m) {
                bf16_t* rowp = O + img_off(row0 + ai * HALF + m * 16, col0, D_FF / 64);
                const f32x4 g0 = acc[ai][0][m][0], g1 = acc[ai][0][m][1], u0 = acc[ai][1][m][0], u1 = acc[ai][1][m][1];
                u32x4 w;
                w.x = cvt_pk_bf16(silu_f(g0[0]) * u0[0], silu_f(g0[1]) * u0[1]); w.y = cvt_pk_bf16(silu_f(g0[2]) * u0[2], silu_f(g0[3]) * u0[3]);
                w.z = cvt_pk_bf16(silu_f(g1[0]) * u1[0], silu_f(g1[1]) * u1[1]); w.w = cvt_pk_bf16(silu_f(g1[2]) * u1[2], silu_f(g1[3]) * u1[3]);
                *(u32x4*)rowp = w;
            }
    }
};
struct EpiAtomic {
    static constexpr bool PERM = false;
    float* X; float* PART; float scale;
    __device__ __forceinline__ void operator()(const f32x4 (&acc)[2][2][4][2], const Unit& u, int wr, int wc, int fr, int fq) const {
        const int row0 = u.pm * BM + wr * 64 + fr, col0 = u.pn * BM + wc * 32 + 4 * fq;
        if (u.part < 0) {
#pragma unroll
            for (int ai = 0; ai < 2; ++ai)
#pragma unroll
                for (int m = 0; m < 4; ++m) {
                    float* rowp = X + (size_t)(row0 + ai * HALF + m * 16) * D_MODEL + col0;
                    f32x4 xv[2][2];
#pragma unroll
                    for (int bj = 0; bj < 2; ++bj)
#pragma unroll
                        for (int n = 0; n < 2; ++n) xv[bj][n] = *(const f32x4*)(rowp + bj * HALF + n * 16);
#pragma unroll
                    for (int bj = 0; bj < 2; ++bj)
#pragma unroll
                        for (int n = 0; n < 2; ++n) *(f32x4*)(rowp + bj * HALF + n * 16) = xv[bj][n] + scale * acc[ai][bj][m][n];
                }
        } else {
            float* base = PART + (size_t)u.part * (512 * 2048);
#pragma unroll
            for (int ai = 0; ai < 2; ++ai)
#pragma unroll
                for (int m = 0; m < 4; ++m) {
                    float* rowp = base + (size_t)(row0 - 8192 + ai * HALF + m * 16) * D_MODEL + col0;
#pragma unroll
                    for (int bj = 0; bj < 2; ++bj)
#pragma unroll
                        for (int n = 0; n < 2; ++n) *(f32x4*)(rowp + bj * HALF + n * 16) = acc[ai][bj][m][n];
                }
        }
    }
};
struct EpiProj {
    static constexpr bool PERM = true;
    bf16_t* P; float* DT;
    __device__ __forceinline__ void operator()(const f32x4 (&acc)[2][2][4][2], const Unit& u, int wr, int wc, int fr, int fq) const {
        const int row0 = u.pm * BM + wr * 64 + fr;
        if (u.pn < 36) {
            const int col0 = u.pn * BM + wc * 32 + 8 * fq;
#pragma unroll
            for (int ai = 0; ai < 2; ++ai)
#pragma unroll
                for (int m = 0; m < 4; ++m) {
                    bf16_t* rowp = P + (size_t)(row0 + ai * HALF + m * 16) * PROJ_LD + col0;
#pragma unroll
                    for (int bj = 0; bj < 2; ++bj) {
                        const f32x4 v0 = acc[ai][bj][m][0], v1 = acc[ai][bj][m][1];
                        u32x4 w; w.x = cvt_pk_bf16(v0[0], v0[1]); w.y = cvt_pk_bf16(v0[2], v0[3]); w.z = cvt_pk_bf16(v1[0], v1[1]); w.w = cvt_pk_bf16(v1[2], v1[3]);
                        *(u32x4*)(rowp + bj * HALF) = w;
                    }
                }
        } else if (wc == 0) {
#pragma unroll
            for (int ai = 0; ai < 2; ++ai)
#pragma unroll
                for (int m = 0; m < 4; ++m) {
                    float* rowp = DT + (size_t)(row0 + ai * HALF + m * 16) * 32 + 8 * fq;
                    *(f32x4*)rowp = acc[ai][0][m][0]; *(f32x4*)(rowp + 4) = acc[ai][0][m][1];
                }
        }
    }
};

template <class Epi, class Sched, int LD>
__device__ __forceinline__ void gemm_phase(LAS unsigned char* lds, const Gemm g, const Sched& S, const Epi& E) {
    const int tid = opaque_tid(), wid = __builtin_amdgcn_readfirstlane(tid >> 6), lane = tid & 63, wr = wid >> 2, wc = wid & 3, fr = lane & 15, fq = lane >> 4;
    constexpr int K = LD;
    unsigned voffA[2], voffB[2];
#pragma unroll
    for (int i = 0; i < 2; ++i) { voffA[i] = (unsigned)(tid * 16 + i * 8192); voffB[i] = voffA[i]; }
    const size_t kstep = (size_t)(2 * HTB);
    const size_t hstep = (size_t)HTB;
    const size_t tstep = (size_t)(K / BK) * kstep;
    const unsigned ldsw = (unsigned)wid * 1024u;
    const int aoff = lds_byte(wr * 64 + fr, fq * 8), boff = lds_byte(wc * 32 + fr, fq * 8);
#define PG8_SA(b, h) (((b) * 2 + (h)) * HTB)
#define PG8_SB(b, h) ((4 + (b) * 2 + (h)) * HTB)
#define PG8_STAGE(bufoff, gbase, voff) do { _Pragma("unroll") for (int _i = 0; _i < 2; ++_i) \
        __builtin_amdgcn_global_load_lds((const unsigned*)((const char*)(gbase) + (voff)[_i]), (LAS unsigned*)(lds + (bufoff) + ldsw + _i * 8192), 16, 0, 0); } while (0)
#define PG8_LDA(dst, b, h) do { _Pragma("unroll") for (int m = 0; m < 4; ++m) _Pragma("unroll") for (int k = 0; k < 2; ++k) dst[m][k] = *(const LAS bf16x8*)(lds + PG8_SA(b, h) + aoff + m * 2048 + k * 1024); } while (0)
#define PG8_LDB(dst, b, h) do { _Pragma("unroll") for (int n = 0; n < 2; ++n) _Pragma("unroll") for (int k = 0; k < 2; ++k) dst[n][k] = *(const LAS bf16x8*)(lds + PG8_SB(b, h) + boff + n * 2048 + k * 1024); } while (0)
#define PG8_MMA(ai, bj, At, Bt) do { __builtin_amdgcn_s_setprio(1); _Pragma("unroll") for (int m = 0; m < 4; ++m) _Pragma("unroll") for (int n = 0; n < 2; ++n) _Pragma("unroll") for (int k = 0; k < 2; ++k) \
        acc[ai][bj][m][n] = __builtin_amdgcn_mfma_f32_16x16x32_bf16(Bt[n][k], At[m][k], acc[ai][bj][m][n], 0, 0, 0); __builtin_amdgcn_s_setprio(0); } while (0)
#define PG8_WAIT_V(n) asm volatile("s_waitcnt vmcnt(" #n ")" ::: "memory")
#define PG8_WAIT_L(n) asm volatile("s_waitcnt lgkmcnt(" #n ")" ::: "memory")
#define PG8_BAR __builtin_amdgcn_s_barrier()
#define PG8_SCHED __builtin_amdgcn_sched_barrier(0)
    Unit cur, nxt; int ui = 0;
    if (!S.next(0, cur)) return;
    f32x4 acc[2][2][4][2];
#pragma unroll
    for (int a = 0; a < 2; ++a)
#pragma unroll
        for (int b = 0; b < 2; ++b)
#pragma unroll
            for (int m = 0; m < 4; ++m)
#pragma unroll
                for (int n = 0; n < 2; ++n) acc[a][b][m][n] = (f32x4){0.f, 0.f, 0.f, 0.f};
    bf16x8 At[4][2], B0[2][2], B1[2][2];
    const char* cA = (const char*)g.A + (size_t)cur.pm * tstep + (size_t)(cur.kofs / BK) * kstep; const char* cB = (const char*)g.Bt + (size_t)cur.pn * tstep + (size_t)(cur.kofs / BK) * kstep;
    PG8_STAGE(PG8_SB(0, 0), cB, voffB); PG8_STAGE(PG8_SA(0, 0), cA, voffA); PG8_STAGE(PG8_SB(0, 1), cB + hstep, voffB); PG8_STAGE(PG8_SA(0, 1), cA + hstep, voffA);
    if (wr == 1) PG8_BAR;
    PG8_WAIT_V(4); PG8_BAR;
    PG8_STAGE(PG8_SB(1, 0), cB + kstep, voffB); PG8_STAGE(PG8_SA(1, 0), cA + kstep, voffA); PG8_STAGE(PG8_SB(1, 1), cB + hstep + kstep, voffB);
    PG8_WAIT_V(6); PG8_BAR;
    for (;;) {
        const bool has_next = S.next(ui + 1, nxt);
        const char* nA = has_next ? (const char*)g.A + (size_t)nxt.pm * tstep + (size_t)(nxt.kofs / BK) * kstep : cA; const char* nB = has_next ? (const char*)g.Bt + (size_t)nxt.pn * tstep + (size_t)(nxt.kofs / BK) * kstep : cB;
        const int nt = cur.nt;
        for (int t = 0; t < nt; t += 2) {
            const bool last = (t == nt - 2);
            const char* a1 = cA + (size_t)(t + 1) * kstep;
            const char* a2 = last ? nA : cA + (size_t)(t + 2) * kstep; const char* b2 = last ? nB : cB + (size_t)(t + 2) * kstep;
            const char* a3 = a2 + kstep; const char* b3 = b2 + kstep;
            PG8_LDB(B0, 0, 0); PG8_SCHED; PG8_LDA(At, 0, 0); PG8_STAGE(PG8_SA(1, 1), a1 + hstep, voffA);
            PG8_WAIT_L(8); PG8_BAR; PG8_WAIT_L(0); PG8_MMA(0, 0, At, B0); PG8_BAR; PG8_SCHED;
            PG8_LDB(B1, 0, 1); PG8_STAGE(PG8_SB(0, 0), b2, voffB);
            PG8_BAR; PG8_WAIT_L(0); PG8_MMA(0, 1, At, B1); PG8_BAR;
            PG8_LDA(At, 0, 1); PG8_STAGE(PG8_SA(0, 0), a2, voffA);
            PG8_BAR; PG8_WAIT_L(0); PG8_MMA(1, 0, At, B0); PG8_BAR; PG8_SCHED;
            PG8_STAGE(PG8_SB(0, 1), b2 + hstep, voffB);
            PG8_WAIT_V(6); PG8_BAR; PG8_MMA(1, 1, At, B1); PG8_BAR;
            PG8_LDB(B0, 1, 0); PG8_SCHED; PG8_LDA(At, 1, 0); PG8_STAGE(PG8_SA(0, 1), a2 + hstep, voffA);
            PG8_WAIT_L(8); PG8_BAR; PG8_WAIT_L(0); PG8_MMA(0, 0, At, B0); PG8_BAR; PG8_SCHED;
            PG8_LDB(B1, 1, 1); PG8_STAGE(PG8_SB(1, 0), b3, voffB);
            PG8_BAR; PG8_WAIT_L(0); PG8_MMA(0, 1, At, B1); PG8_BAR;
            PG8_LDA(At, 1, 1); PG8_STAGE(PG8_SA(1, 0), a3, voffA);
            PG8_BAR; PG8_WAIT_L(0); PG8_MMA(1, 0, At, B0); PG8_BAR; PG8_SCHED;
            PG8_STAGE(PG8_SB(1, 1), b3 + hstep, voffB);
            PG8_WAIT_V(6); PG8_BAR; PG8_MMA(1, 1, At, B1); PG8_BAR;
        }
        E(acc, cur, wr, wc, fr, fq);
        if (!has_next) break;
#pragma unroll
        for (int a = 0; a < 2; ++a)
#pragma unroll
            for (int b = 0; b < 2; ++b)
#pragma unroll
                for (int m = 0; m < 4; ++m)
#pragma unroll
                    for (int n = 0; n < 2; ++n) acc[a][b][m][n] = (f32x4){0.f, 0.f, 0.f, 0.f};
        cur = nxt; cA = nA; cB = nB; ++ui;
    }
    PG8_WAIT_V(0);
    if (wr == 0) PG8_BAR;
    PG8_BAR;
#undef PG8_SA
#undef PG8_SB
#undef PG8_STAGE
#undef PG8_LDA
#undef PG8_LDB
#undef PG8_MMA
#undef PG8_WAIT_V
#undef PG8_WAIT_L
#undef PG8_BAR
#undef PG8_SCHED
}
}

struct TileInfo { const float* src; bf16_t* dst; int K, N, k0, n0, mode, perm; };
constexpr int CONV_TILES_LAYER = 6 * 352 + 580 + 192;

__device__ __forceinline__ void conv_decode(const Params& p, int t, TileInfo& ti) {
    const int layer = t / CONV_TILES_LAYER; int r = t % CONV_TILES_LAYER;
    unsigned char* wl = p.ws + (size_t)layer * SZ_LAYERW;
    int ntn;
    if (r < 352)       { ti.src = inp(p, 6)  + (size_t)layer * 2048 * 5632; ti.dst = (bf16_t*)(wl + OFF_WGU1); ti.K = 2048; ti.N = 5632; ti.mode = 1; ti.perm = 1; ntn = 88; }
    else if (r < 704)  { r -= 352;  ti.src = inp(p, 7)  + (size_t)layer * 2048 * 5632; ti.dst = (bf16_t*)(wl + OFF_WGU1); ti.K = 2048; ti.N = 5632; ti.mode = 2; ti.perm = 1; ntn = 88; }
    else if (r < 1056) { r -= 704;  ti.src = inp(p, 8)  + (size_t)layer * 5632 * 2048; ti.dst = (bf16_t*)(wl + OFF_WD1);  ti.K = 5632; ti.N = 2048; ti.mode = 0; ti.perm = 0; ntn = 32; }
    else if (r < 1636) { r -= 1056; ti.src = inp(p, 10) + (size_t)layer * 2048 * N_IN; ti.dst = (bf16_t*)(wl + OFF_WIN);  ti.K = 2048; ti.N = N_IN; ti.mode = 0; ti.perm = 1; ntn = 145; }
    else if (r < 1828) { r -= 1636; ti.src = inp(p, 18) + (size_t)layer * 3072 * 2048; ti.dst = (bf16_t*)(wl + OFF_WOUT); ti.K = 3072; ti.N = 2048; ti.mode = 0; ti.perm = 0; ntn = 32; }
    else if (r < 2180) { r -= 1828; ti.src = inp(p, 20) + (size_t)layer * 2048 * 5632; ti.dst = (bf16_t*)(wl + OFF_WGU2); ti.K = 2048; ti.N = 5632; ti.mode = 1; ti.perm = 1; ntn = 88; }
    else if (r < 2532) { r -= 2180; ti.src = inp(p, 21) + (size_t)layer * 2048 * 5632; ti.dst = (bf16_t*)(wl + OFF_WGU2); ti.K = 2048; ti.N = 5632; ti.mode = 2; ti.perm = 1; ntn = 88; }
    else               { r -= 2532; ti.src = inp(p, 22) + (size_t)layer * 5632 * 2048; ti.dst = (bf16_t*)(wl + OFF_WD2);  ti.K = 5632; ti.N = 2048; ti.mode = 0; ti.perm = 0; ntn = 32; }
    ti.k0 = (r / ntn) * 512; ti.n0 = (r % ntn) * 64;
}
__device__ __forceinline__ void conv_load(const TileInfo& ti, f32x4 (&r)[16], int tid) {
    const int lane = tid & 63, wave = tid >> 6, n = ti.n0 + (lane & 15) * 4, k = ti.k0 + wave * 64 + (lane >> 4) * 16;
#pragma unroll
    for (int i = 0; i < 16; ++i) {
        if (n < ti.N) r[i] = __builtin_nontemporal_load((const f32x4*)(ti.src + (size_t)(k + i) * ti.N + n));
        else r[i] = (f32x4){0.f, 0.f, 0.f, 0.f};
    }
}
__device__ void phase_convert(const Params& p, unsigned char* lds_raw) {
    const int tid = opaque_tid();
    constexpr int NT_TOTAL = 2 * CONV_TILES_LAYER;
    f32x4 r[16], rn[16];
    int t = blockIdx.x; asm volatile("" : "+s"(t));
    if (t < NT_TOTAL) { TileInfo t0; conv_decode(p, t, t0); conv_load(t0, r, tid); }
    for (; t < NT_TOTAL; t += gridDim.x) {
        const int tn = t + gridDim.x;
        if (tn < NT_TOTAL) { TileInfo tin; conv_decode(p, tn, tin); conv_load(tin, rn, tid); }
        {
            TileInfo ti; conv_decode(p, t, ti);
            const int lane = tid & 63, wave = tid >> 6, n = ti.n0 + (lane & 15) * 4, k = ti.k0 + wave * 64 + (lane >> 4) * 16;
            if (n < ti.N) {
#pragma unroll
                for (int j = 0; j < 4; ++j) {
                    u32x4 w0, w1;
                    w0.x = cvt_pk_bf16(r[0][j], r[1][j]);  w0.y = cvt_pk_bf16(r[2][j], r[3][j]);   w0.z = cvt_pk_bf16(r[4][j], r[5][j]);   w0.w = cvt_pk_bf16(r[6][j], r[7][j]);
                    w1.x = cvt_pk_bf16(r[8][j], r[9][j]);  w1.y = cvt_pk_bf16(r[10][j], r[11][j]); w1.z = cvt_pk_bf16(r[12][j], r[13][j]); w1.w = cvt_pk_bf16(r[14][j], r[15][j]);
                    const int nn = n + j;
                    int row = nn;
                    if (ti.mode == 1) row = (nn >> 7) * 256 + (nn & 127);
                    else if (ti.mode == 2) row = (nn >> 7) * 256 + 128 + (nn & 127);
                    if (ti.perm) row = (row & ~31) + pg8::perm32_inv(row & 31);
                    *(u32x4*)(ti.dst + pg8::img_off(row, k, ti.K >> 6)) = w0; *(u32x4*)(ti.dst + pg8::img_off(row, k + 8, ti.K >> 6)) = w1;
                }
            }
        }
#pragma unroll
        for (int i = 0; i < 16; ++i) r[i] = rn[i];
    }
    for (int layer = 0; layer < 2; ++layer) {
        bf16_t* wz = (bf16_t*)(p.ws + (size_t)layer * SZ_LAYERW + OFF_WIN);
        for (int i = blockIdx.x * NTHREADS + tid; i < (N_IN_PAD - N_IN) * 256; i += gridDim.x * NTHREADS)
            *(u32x4*)(wz + pg8::img_off(N_IN + (i >> 8), (i & 255) * 8, 32)) = (u32x4){0u, 0u, 0u, 0u};
    }
}

template <int MODE>
__device__ __forceinline__ void norm_row(const Params& p, const f32x4 (&g)[8], int r, int lane, int nparts, float pscale) {
    float* X = (float*)(p.ws + WS_X); bf16_t* H = (bf16_t*)(p.ws + WS_H);
    const float* src = (MODE == 0) ? (r < 8192 ? inp(p, 0) + (size_t)r * 2048 : inp(p, 1) + (size_t)(r - 8192) * 2048) : X + (size_t)r * 2048;
    f32x4 v[8]; float ss = 0.f;
#pragma unroll
    for (int i = 0; i < 8; ++i) v[i] = *(const f32x4*)(src + i * 256 + lane * 4);
    if (MODE != 0 && nparts > 0 && r >= 8192) {
        const float* pp = (const float*)(p.ws + WS_ST) + (size_t)(r - 8192) * 2048 + lane * 4;
        f32x4 a[8];
#pragma unroll
        for (int i = 0; i < 8; ++i) a[i] = (f32x4){0.f, 0.f, 0.f, 0.f};
        for (int k = 0; k < nparts; ++k) {
#pragma unroll
            for (int i = 0; i < 8; ++i) a[i] += *(const f32x4*)(pp + (size_t)k * (512 * 2048) + i * 256);
        }
#pragma unroll
        for (int i = 0; i < 8; ++i) { v[i] += pscale * a[i]; *(f32x4*)(X + (size_t)r * 2048 + i * 256 + lane * 4) = v[i]; }
    }
#pragma unroll
    for (int i = 0; i < 8; ++i) ss += v[i][0] * v[i][0] + v[i][1] * v[i][1] + v[i][2] * v[i][2] + v[i][3] * v[i][3];
#pragma unroll
    for (int o = 32; o >= 1; o >>= 1) ss += __shfl_xor(ss, o);
    const float rstd = rsqrtf(ss * (1.f / 2048.f) + EPS);
#pragma unroll
    for (int i = 0; i < 8; ++i) {
        if (MODE == 0) *(f32x4*)(X + (size_t)r * 2048 + i * 256 + lane * 4) = v[i];
        const f32x4 o = v[i] * rstd * g[i];
        if (MODE < 2) { u32x2 w; w.x = cvt_pk_bf16(o[0], o[1]); w.y = cvt_pk_bf16(o[2], o[3]); *(u32x2*)(H + pg8::img_off(r, i * 256 + lane * 4, 32)) = w; }
        else *(f32x4*)(p.out + (size_t)r * 2048 + i * 256 + lane * 4) = o;
    }
}
template <int MODE>
__device__ void phase_norm(const Params& p, const float* gamma, int nparts, float pscale) {
    const int tid = opaque_tid(), lane = tid & 63, wave = tid >> 6;
    f32x4 g[8];
#pragma unroll
    for (int i = 0; i < 8; ++i) g[i] = *(const f32x4*)(gamma + i * 256 + lane * 4);
    if (wave < 2) for (int s = blockIdx.x * 2 + wave; s < 512; s += gridDim.x * 2) norm_row<MODE>(p, g, 8192 + s, lane, nparts, pscale);
    for (int r = blockIdx.x * 8 + wave; r < 8192; r += gridDim.x * 8) norm_row<MODE>(p, g, r, lane, nparts, pscale);
}

__device__ __forceinline__ u32x4 fetch_xbc8(const bf16_t* proj, const float* hist, int c, int lrow, int col) {
    if (lrow >= 0 || (c > 0 && c < NPCH)) return *(const u32x4*)(proj + (size_t)(c * 64 + lrow) * PROJ_LD + 5120 + col);
    if (c == 0) return (u32x4){0u, 0u, 0u, 0u};
    const float* h = hist + ((size_t)(c - NPCH) * 3 + (3 + lrow)) * 4096 + col;
    const f32x4 a = *(const f32x4*)h, b = *(const f32x4*)(h + 4);
    u32x4 w; w.x = cvt_pk_bf16(a[0], a[1]); w.y = cvt_pk_bf16(a[2], a[3]); w.z = cvt_pk_bf16(b[0], b[1]); w.w = cvt_pk_bf16(b[2], b[3]);
    return w;
}
__device__ __forceinline__ void dt_acum(const Params& p, int layer, int c, int h, int lane, float& dtv, float& acum, float& total) {
    const float* DT = (const float*)(p.ws + WS_DT);
    const float raw = DT[(size_t)(c * 64 + lane) * 32 + h];
    dtv = softplus_f(raw + inp(p, 14)[layer * 32 + h]);
    const float A = -expf(inp(p, 15)[layer * 32 + h]);
    float a = dtv * A;
#pragma unroll
    for (int o = 1; o < 64; o <<= 1) { const float t = __shfl_up(a, o); if (lane >= o) a += t; }
    acum = a; total = __shfl(a, 63);
}

__device__ void phase_s1(const Params& p, int layer, unsigned char* lds) {
    bf16_t* s_xwT = (bf16_t*)lds;
    bf16_t* s_BT = (bf16_t*)(lds + 36864);
    float* s_w = (float*)(lds + 55296);
    const int tid = opaque_tid(), lane = tid & 63, wave = tid >> 6, fr = lane & 15, fq = lane >> 4;
    const bf16_t* proj = (const bf16_t*)(p.ws + WS_PROJ);
    bf16_t* mix = (bf16_t*)(p.ws + WS_MIX);
    bf16_t* ST = (bf16_t*)(p.ws + WS_ST);
    float* DEC = (float*)(p.ws + WS_DEC);
    const float* hist = inp(p, 3) + (size_t)layer * 8 * 3 * 4096;
    for (int unit = blockIdx.x; unit < NCHUNK * 8; unit += gridDim.x) {
        const int c = unit >> 3, g = unit & 7, row0 = c * 64;
        const bool last_chunk = (c >= NPCH - 1);
        if (wave < 4) {
            const int h = g * 4 + wave; float dtv, acum, total;
            dt_acum(p, layer, c, h, lane, dtv, acum, total);
            s_w[wave * 64 + lane] = dtv * __expf(total - acum);
            if (lane == 0) DEC[c * 32 + h] = __expf(total);
        }
        __syncthreads();
        if (tid < 384) {
            const int rr = tid & 7, cg = tid >> 3, l0 = rr * 8;
            const int col = (cg < 32) ? g * 256 + cg * 8 : 2048 + g * 128 + (cg - 32) * 8;
            u32x4 rows[11];
#pragma unroll
            for (int i = 0; i < 11; ++i) rows[i] = fetch_xbc8(proj, hist, c, l0 - 3 + i, col);
            const float* cw = inp(p, 12) + (size_t)layer * 4 * 4096 + col; const float* cb = inp(p, 13) + (size_t)layer * 4096 + col;
            float w[4][8], b[8];
#pragma unroll
            for (int k = 0; k < 4; ++k) { const f32x4 a = *(const f32x4*)(cw + k * 4096), bb = *(const f32x4*)(cw + k * 4096 + 4);
#pragma unroll
                for (int j = 0; j < 4; ++j) { w[k][j] = a[j]; w[k][4 + j] = bb[j]; } }
            { const f32x4 a = *(const f32x4*)cb, bb = *(const f32x4*)(cb + 4);
#pragma unroll
              for (int j = 0; j < 4; ++j) { b[j] = a[j]; b[4 + j] = bb[j]; } }
            float sc[8];
#pragma unroll
            for (int i = 0; i < 8; ++i) sc[i] = (cg < 32) ? s_w[(cg >> 3) * 64 + l0 + i] : 1.f;
            bf16_t* dstT = (cg < 32) ? s_xwT + (cg * 8) * 72 + l0 : s_BT + ((cg - 32) * 8) * 72 + l0;
#pragma unroll
            for (int j = 0; j < 8; ++j) {
                float o[8];
#pragma unroll
                for (int i = 0; i < 8; ++i) {
                    float v = b[j];
#pragma unroll
                    for (int k = 0; k < 4; ++k) v += w[k][j] * bfv(rows[i + k], j);
                    o[i] = silu_f(v) * sc[i];
                }
                u32x4 pk; pk.x = cvt_pk_bf16(o[0], o[1]); pk.y = cvt_pk_bf16(o[2], o[3]); pk.z = cvt_pk_bf16(o[4], o[5]); pk.w = cvt_pk_bf16(o[6], o[7]);
                *(u32x4*)(dstT + j * 72) = pk;
            }
        } else {
            const int t2 = tid - 384, rr = t2 & 7, cgi = t2 >> 3, l0 = rr * 8, ch0 = g * 128 + cgi * 8;
            const float* scw = inp(p, 11) + (size_t)layer * 3 * 1024 + ch0;
            float w[3][8];
#pragma unroll
            for (int k = 0; k < 3; ++k) { const f32x4 a = *(const f32x4*)(scw + k * 1024), bb = *(const f32x4*)(scw + k * 1024 + 4);
#pragma unroll
                for (int j = 0; j < 4; ++j) { w[k][j] = a[j]; w[k][4 + j] = bb[j]; } }
            float um2[8], um1[8], u0[8];
#pragma unroll
            for (int i = 0; i < 10; ++i) {
                const int lrow = l0 - 2 + i;
#pragma unroll
                for (int j = 0; j < 8; ++j) { um2[j] = um1[j]; um1[j] = u0[j]; }
                if (lrow >= 0 || (c > 0 && c < NPCH)) {
                    const bf16_t* rp = proj + (size_t)(row0 + lrow) * PROJ_LD + ch0;
                    const u32x4 cv = *(const u32x4*)(rp + 1024), xv = *(const u32x4*)(rp + 2048);
#pragma unroll
                    for (int j = 0; j < 8; ++j) u0[j] = bfv(cv, j) * bfv(xv, j);
                } else if (c == 0) {
#pragma unroll
                    for (int j = 0; j < 8; ++j) u0[j] = 0.f;
                } else {
                    const float* hp = inp(p, 2) + (((size_t)layer * 8 + (c - NPCH)) * 2 + (2 + lrow)) * 1024 + ch0;
                    const f32x4 a = *(const f32x4*)hp, bb = *(const f32x4*)(hp + 4);
#pragma unroll
                    for (int j = 0; j < 4; ++j) { u0[j] = a[j]; u0[4 + j] = bb[j]; }
                }
                if (i >= 2) {
                    const int l = l0 + i - 2;
                    const u32x4 bv = *(const u32x4*)(proj + (size_t)(row0 + l) * PROJ_LD + ch0);
                    float y[8];
#pragma unroll
                    for (int j = 0; j < 8; ++j) y[j] = bfv(bv, j) * (w[0][j] * um2[j] + w[1][j] * um1[j] + w[2][j] * u0[j]);
                    u32x4 pk; pk.x = cvt_pk_bf16(y[0], y[1]); pk.y = cvt_pk_bf16(y[2], y[3]); pk.z = cvt_pk_bf16(y[4], y[5]); pk.w = cvt_pk_bf16(y[6], y[7]);
                    *(u32x4*)(mix + pg8::img_off(row0 + l, ch0, D_MIX / 64)) = pk;
                    if (last_chunk && l >= 62) {
                        float* op = (c < NPCH) ? p.out + O_SC_P + ((size_t)layer * 2 + (l - 62)) * 1024 + ch0
                                               : p.out + O_SC_S + (((size_t)layer * 8 + (c - NPCH)) * 2 + (l - 62)) * 1024 + ch0;
                        *(f32x4*)op = (f32x4){u0[0], u0[1], u0[2], u0[3]}; *(f32x4*)(op + 4) = (f32x4){u0[4], u0[5], u0[6], u0[7]};
                    }
                }
            }
        }
        __syncthreads();
        {
            const int hh = wave >> 1, half = wave & 1, h = g * 4 + hh;
            f32x4 acc[4][4];
#pragma unroll
            for (int a = 0; a < 4; ++a)
#pragma unroll
                for (int b = 0; b < 4; ++b) acc[a][b] = (f32x4){0.f, 0.f, 0.f, 0.f};
#pragma unroll
            for (int ks = 0; ks < 2; ++ks) {
                bf16x8 af[4], bfr[4];
#pragma unroll
                for (int a = 0; a < 4; ++a) af[a] = *(const bf16x8*)(s_BT + (half * 64 + a * 16 + fr) * 72 + ks * 32 + fq * 8);
#pragma unroll
                for (int b = 0; b < 4; ++b) bfr[b] = *(const bf16x8*)(s_xwT + (hh * 64 + b * 16 + fr) * 72 + ks * 32 + fq * 8);
#pragma unroll
                for (int a = 0; a < 4; ++a)
#pragma unroll
                    for (int b = 0; b < 4; ++b) acc[a][b] = __builtin_amdgcn_mfma_f32_16x16x32_bf16(af[a], bfr[b], acc[a][b], 0, 0, 0);
            }
            bf16_t* stp = ST + ((size_t)(c * 32 + h) * 64) * 128;
#pragma unroll
            for (int a = 0; a < 4; ++a)
#pragma unroll
                for (int b = 0; b < 4; ++b) {
                    u32x2 w; w.x = cvt_pk_bf16(acc[a][b][0], acc[a][b][1]); w.y = cvt_pk_bf16(acc[a][b][2], acc[a][b][3]);
                    *(u32x2*)(stp + (size_t)(b * 16 + fr) * 128 + half * 64 + a * 16 + fq * 4) = w;
                }
        }
        __syncthreads();
    }
}

__device__ void phase_s2(const Params& p, int layer) {
    unsigned* ST32 = (unsigned*)(p.ws + WS_ST);
    const float* DEC = (const float*)(p.ws + WS_DEC);
    constexpr int NP = 32 * 64 * 128 / 2;
    const int gtid = blockIdx.x * NTHREADS + opaque_tid(), nth = gridDim.x * NTHREADS;
    for (int idx = gtid; idx < NP; idx += nth) {
        const int h = idx >> 12;
        float s0 = 0.f, s1 = 0.f;
        for (int c0 = 0; c0 < NPCH; c0 += 16) {
            unsigned v[16]; float d[16];
#pragma unroll
            for (int j = 0; j < 16; ++j) { v[j] = ST32[(size_t)(c0 + j) * NP + idx]; d[j] = DEC[(c0 + j) * 32 + h]; }
#pragma unroll
            for (int j = 0; j < 16; ++j) {
                ST32[(size_t)(c0 + j) * NP + idx] = cvt_pk_bf16(s0, s1);
                s0 = s0 * d[j] + bf_lo(v[j]); s1 = s1 * d[j] + bf_hi(v[j]);
            }
        }
        *(f32x2*)(p.out + O_SSM_P + (size_t)layer * 262144 + 2 * (size_t)idx) = (f32x2){s0, s1};
    }
    for (int it = gtid; it < 8 * NP; it += nth) {
        const int b = it / NP, idx = it % NP, h = idx >> 12;
        const f32x2 s = *(const f32x2*)(inp(p, 4) + ((size_t)layer * 8 + b) * 262144 + 2 * (size_t)idx);
        const unsigned v = ST32[(size_t)(NPCH + b) * NP + idx];
        const float d = DEC[(NPCH + b) * 32 + h];
        ST32[(size_t)(NPCH + b) * NP + idx] = cvt_pk_bf16(s[0], s[1]);
        *(f32x2*)(p.out + O_SSM_S + ((size_t)layer * 8 + b) * 262144 + 2 * (size_t)idx) = (f32x2){s[0] * d + bf_lo(v), s[1] * d + bf_hi(v)};
    }
}

__device__ void phase_s3(const Params& p, int layer, unsigned char* lds) {
    bf16_t* s_xsT = (bf16_t*)lds;
    bf16_t* s_B = (bf16_t*)(lds + 36864);
    bf16_t* s_C = (bf16_t*)(lds + 36864 + 17408);
    bf16_t* s_M = (bf16_t*)(lds + 71680);
    float* s_dt = (float*)(lds + 108544);
    float* s_acum = s_dt + 256;
    float* s_ssq = s_acum + 256;
    const int tid = opaque_tid(), lane = tid & 63, wave = tid >> 6, fr = lane & 15, fq = lane >> 4;
    const bf16_t* proj = (const bf16_t*)(p.ws + WS_PROJ);
    bf16_t* mix = (bf16_t*)(p.ws + WS_MIX);
    const bf16_t* ST = (const bf16_t*)(p.ws + WS_ST);
    const float* hist = inp(p, 3) + (size_t)layer * 8 * 3 * 4096;
    for (int unit = blockIdx.x; unit < NCHUNK * 8; unit += gridDim.x) {
        const int c = unit >> 3, g = unit & 7, row0 = c * 64;
        const bool last_chunk = (c >= NPCH - 1);
        if (wave < 4) {
            const int h = g * 4 + wave; float dtv, acum, total;
            dt_acum(p, layer, c, h, lane, dtv, acum, total);
            s_dt[wave * 64 + lane] = dtv; s_acum[wave * 64 + lane] = acum;
        }
        {
            const int rr = tid & 7, cg = tid >> 3, l0 = rr * 8;
            const int col = (cg < 32) ? g * 256 + cg * 8 : (cg < 48 ? 2048 + g * 128 + (cg - 32) * 8 : 3072 + g * 128 + (cg - 48) * 8);
            u32x4 rows[11];
#pragma unroll
            for (int i = 0; i < 11; ++i) rows[i] = fetch_xbc8(proj, hist, c, l0 - 3 + i, col);
            const float* cw = inp(p, 12) + (size_t)layer * 4 * 4096 + col; const float* cb = inp(p, 13) + (size_t)layer * 4096 + col;
            float w[4][8], b[8];
#pragma unroll
            for (int k = 0; k < 4; ++k) { const f32x4 a = *(const f32x4*)(cw + k * 4096), bb = *(const f32x4*)(cw + k * 4096 + 4);
#pragma unroll
                for (int j = 0; j < 4; ++j) { w[k][j] = a[j]; w[k][4 + j] = bb[j]; } }
            { const f32x4 a = *(const f32x4*)cb, bb = *(const f32x4*)(cb + 4);
#pragma unroll
              for (int j = 0; j < 4; ++j) { b[j] = a[j]; b[4 + j] = bb[j]; } }
            if (last_chunk && rr == 7) {
#pragma unroll
                for (int i = 0; i < 3; ++i) {
                    float* op = (c < NPCH) ? p.out + O_CONV_P + ((size_t)layer * 3 + i) * 4096 + col
                                           : p.out + O_CONV_S + (((size_t)layer * 8 + (c - NPCH)) * 3 + i) * 4096 + col;
                    const u32x4 rv = rows[8 + i];
                    *(f32x4*)op = (f32x4){bf_lo(rv.x), bf_hi(rv.x), bf_lo(rv.y), bf_hi(rv.y)}; *(f32x4*)(op + 4) = (f32x4){bf_lo(rv.z), bf_hi(rv.z), bf_lo(rv.w), bf_hi(rv.w)};
                }
            }
            if (cg < 32) {
#pragma unroll
                for (int j = 0; j < 8; ++j) {
                    float o[8];
#pragma unroll
                    for (int i = 0; i < 8; ++i) {
                        float v = b[j];
#pragma unroll
                        for (int k = 0; k < 4; ++k) v += w[k][j] * bfv(rows[i + k], j);
                        o[i] = silu_f(v);
                    }
                    u32x4 pk; pk.x = cvt_pk_bf16(o[0], o[1]); pk.y = cvt_pk_bf16(o[2], o[3]); pk.z = cvt_pk_bf16(o[4], o[5]); pk.w = cvt_pk_bf16(o[6], o[7]);
                    *(u32x4*)(s_xsT + (cg * 8 + j) * 72 + l0) = pk;
                }
            } else {
                bf16_t* dst = (cg < 48) ? s_B + (cg - 32) * 8 : s_C + (cg - 48) * 8;
#pragma unroll
                for (int i = 0; i < 8; ++i) {
                    float o[8];
#pragma unroll
                    for (int j = 0; j < 8; ++j) {
                        float v = b[j];
#pragma unroll
                        for (int k = 0; k < 4; ++k) v += w[k][j] * bfv(rows[i + k], j);
                        o[j] = silu_f(v);
                    }
                    u32x4 pk; pk.x = cvt_pk_bf16(o[0], o[1]); pk.y = cvt_pk_bf16(o[2], o[3]); pk.z = cvt_pk_bf16(o[4], o[5]); pk.w = cvt_pk_bf16(o[6], o[7]);
                    *(u32x4*)(dst + (l0 + i) * 136) = pk;
                }
            }
        }
        __syncthreads();
        const int hh_y = wave >> 1, half_y = wave & 1, h_y = g * 4 + hh_y;
        u32x2 zv[2][4];
#pragma unroll
        for (int lti = 0; lti < 2; ++lti)
#pragma unroll
            for (int pt = 0; pt < 4; ++pt) zv[lti][pt] = *(const u32x2*)(proj + (size_t)(row0 + (2 * half_y + lti) * 16 + fr) * PROJ_LD + 3072 + h_y * 64 + pt * 16 + fq * 4);
        bf16x8 aPall[4][4];
        {
            const bf16_t* prev = ST + ((size_t)(c * 32 + h_y) * 64) * 128;
#pragma unroll
            for (int ks = 0; ks < 4; ++ks)
#pragma unroll
                for (int pt = 0; pt < 4; ++pt) aPall[ks][pt] = *(const bf16x8*)(prev + (size_t)(pt * 16 + fr) * 128 + ks * 32 + fq * 8);
        }
        {
            const int lt = wave >> 1;
#pragma unroll
            for (int sti = 0; sti < 2; ++sti) {
                const int st = (wave & 1) * 2 + sti;
                f32x4 acc = (f32x4){0.f, 0.f, 0.f, 0.f};
                if (st <= lt) {
#pragma unroll
                    for (int ks = 0; ks < 4; ++ks) {
                        const bf16x8 a = *(const bf16x8*)(s_C + (lt * 16 + fr) * 136 + ks * 32 + fq * 8);
                        const bf16x8 b = *(const bf16x8*)(s_B + (st * 16 + fr) * 136 + ks * 32 + fq * 8);
                        acc = __builtin_amdgcn_mfma_f32_16x16x32_bf16(a, b, acc, 0, 0, 0);
                    }
                }
                const int s = st * 16 + fr;
#pragma unroll
                for (int hh = 0; hh < 4; ++hh) {
                    const float as = s_acum[hh * 64 + s], ds = s_dt[hh * 64 + s], Dh = inp(p, 16)[layer * 32 + g * 4 + hh];
#pragma unroll
                    for (int r = 0; r < 4; ++r) {
                        const int l = lt * 16 + fq * 4 + r;
                        float v = 0.f;
                        if (s <= l) v = acc[r] * __expf(s_acum[hh * 64 + l] - as) * ds;
                        if (s == l) v += Dh;
                        s_M[(hh * 64 + l) * 72 + s] = (bf16_t)(cvt_pk_bf16(v, 0.f) & 0xffffu);
                    }
                }
            }
        }
        __syncthreads();
        {
            const int hh = wave >> 1, half = wave & 1, h = g * 4 + hh;
            f32x4 acc1[2][4], acc2[2][4];
#pragma unroll
            for (int a = 0; a < 2; ++a)
#pragma unroll
                for (int b = 0; b < 4; ++b) { acc1[a][b] = (f32x4){0.f, 0.f, 0.f, 0.f}; acc2[a][b] = (f32x4){0.f, 0.f, 0.f, 0.f}; }
#pragma unroll
            for (int ks = 0; ks < 4; ++ks) {
                bf16x8 bC[2];
#pragma unroll
                for (int lti = 0; lti < 2; ++lti) bC[lti] = *(const bf16x8*)(s_C + ((2 * half + lti) * 16 + fr) * 136 + ks * 32 + fq * 8);
#pragma unroll
                for (int lti = 0; lti < 2; ++lti)
#pragma unroll
                    for (int pt = 0; pt < 4; ++pt) acc2[lti][pt] = __builtin_amdgcn_mfma_f32_16x16x32_bf16(aPall[ks][pt], bC[lti], acc2[lti][pt], 0, 0, 0);
            }
#pragma unroll
            for (int ks = 0; ks < 2; ++ks) {
                bf16x8 bM[2], aX[4];
#pragma unroll
                for (int lti = 0; lti < 2; ++lti) bM[lti] = *(const bf16x8*)(s_M + (hh * 64 + (2 * half + lti) * 16 + fr) * 72 + ks * 32 + fq * 8);
#pragma unroll
                for (int pt = 0; pt < 4; ++pt) aX[pt] = *(const bf16x8*)(s_xsT + (hh * 64 + pt * 16 + fr) * 72 + ks * 32 + fq * 8);
#pragma unroll
                for (int lti = 0; lti < 2; ++lti)
#pragma unroll
                    for (int pt = 0; pt < 4; ++pt) acc1[lti][pt] = __builtin_amdgcn_mfma_f32_16x16x32_bf16(aX[pt], bM[lti], acc1[lti][pt], 0, 0, 0);
            }
#pragma unroll
            for (int lti = 0; lti < 2; ++lti) {
                const int l = (2 * half + lti) * 16 + fr;
                const float e = __expf(s_acum[hh * 64 + l]);
                float ss = 0.f;
#pragma unroll
                for (int pt = 0; pt < 4; ++pt) {
                    const float z0 = bf_lo(zv[lti][pt].x), z1 = bf_hi(zv[lti][pt].x), z2 = bf_lo(zv[lti][pt].y), z3 = bf_hi(zv[lti][pt].y);
                    f32x4 u = acc1[lti][pt] + e * acc2[lti][pt];
                    u[0] *= silu_f(z0); u[1] *= silu_f(z1); u[2] *= silu_f(z2); u[3] *= silu_f(z3);
                    acc1[lti][pt] = u;
                    ss += u[0] * u[0] + u[1] * u[1] + u[2] * u[2] + u[3] * u[3];
                }
                ss += __shfl_xor(ss, 16); ss += __shfl_xor(ss, 32);
                if (fq == 0) s_ssq[hh * 64 + l] = ss;
            }
            __syncthreads();
            const float* nw = inp(p, 17) + (size_t)layer * 2048 + h * 64;
#pragma unroll
            for (int lti = 0; lti < 2; ++lti) {
                const int l = (2 * half + lti) * 16 + fr;
                const float scale = rsqrtf(((s_ssq[l] + s_ssq[64 + l]) + (s_ssq[128 + l] + s_ssq[192 + l])) * (1.f / 256.f) + EPS);
#pragma unroll
                for (int pt = 0; pt < 4; ++pt) {
                    const f32x4 w4 = *(const f32x4*)(nw + pt * 16 + fq * 4);
                    const f32x4 o = acc1[lti][pt] * scale * w4;
                    u32x2 w; w.x = cvt_pk_bf16(o[0], o[1]); w.y = cvt_pk_bf16(o[2], o[3]);
                    *(u32x2*)(mix + pg8::img_off(row0 + l, 1024 + h * 64 + pt * 16 + fq * 4, D_MIX / 64)) = w;
                }
            }
        }
        __syncthreads();
    }
}

#define XB_TMO      128
#define XB_XCNT(j)  (256  + 64 * (j))
#define XB_XSUB(j)  (1280 + 64 * (j))
#define XB_XGEN(j)  (2304 + 64 * (j))
#define XB_TOP      3328
#define XB_TOPGEN   3392
#define XCD_BAR_WORDS 3456
#define XB_SPIN_CAP (1u << 18)

__device__ __forceinline__ unsigned xb_ld(unsigned* p)              { return __hip_atomic_load(p, __ATOMIC_RELAXED, __HIP_MEMORY_SCOPE_AGENT); }
__device__ __forceinline__ unsigned xb_add(unsigned* p, unsigned v) { return __hip_atomic_fetch_add(p, v, __ATOMIC_RELAXED, __HIP_MEMORY_SCOPE_AGENT); }
__device__ __forceinline__ unsigned xb_xcc_id() { return (unsigned)__builtin_amdgcn_s_getreg((3 << 11) | 20) & 0xFu; }
#define XB_SPIN(cond, bar) do { unsigned _sp = 0; while (cond) { __builtin_amdgcn_s_sleep(1); \
    if ((++_sp & 255u) == 0u) { if (xb_ld(&(bar)[XB_TMO])) break; if (_sp > XB_SPIN_CAP) { atomicAdd(&(bar)[XB_TMO], 1u); break; } } } } while (0)

struct XcdBarrier {
    unsigned* bar; unsigned x;
    volatile LAS unsigned* st;
};

__device__ __forceinline__ XcdBarrier xcd_barrier_post(unsigned* bar, volatile LAS unsigned* st) {
    XcdBarrier b; b.bar = bar; b.x = xb_xcc_id(); b.st = st;
    if (threadIdx.x == 0) (void)xb_add(&bar[XB_XCNT(b.x)], 1u);
    return b;
}
__device__ __forceinline__ void xcd_barrier_complete(unsigned* bar, unsigned x, unsigned& nloc, unsigned& nx) {
    const unsigned G = gridDim.x * gridDim.y * gridDim.z;
    unsigned sum, cnt, mine, sp = 0u;
    for (;;) {
        sum = 0u; cnt = 0u; mine = 0u;
#pragma unroll
        for (unsigned j = 0; j < 16; ++j) { const unsigned c = xb_ld(&bar[XB_XCNT(j)]); sum += c; cnt += (c > 0u) ? 1u : 0u; mine = (j == x) ? c : mine; }
        if (sum == G) break;
        __builtin_amdgcn_s_sleep(1);
        if ((++sp & 255u) == 0u) { if (xb_ld(&bar[XB_TMO])) break; if (sp > XB_SPIN_CAP) { atomicAdd(&bar[XB_TMO], 1u); break; } }
    }
    nloc = mine > 0u ? mine : 1u; nx = cnt > 0u ? cnt : 1u;
}

__device__ __forceinline__ void xcd_barrier(const XcdBarrier& b) {
    asm volatile("s_waitcnt vmcnt(0)" ::: "memory");
    __syncthreads();
    if (threadIdx.x == 0) {
        unsigned* bar = b.bar;
        __builtin_amdgcn_s_waitcnt(0);
        unsigned nloc = b.st[0], nx = b.st[1];
        if (nloc == 0u) { xcd_barrier_complete(bar, b.x, nloc, nx); b.st[0] = nloc; b.st[1] = nx; }
        const unsigned old = xb_add(&bar[XB_XSUB(b.x)], 1u);
        const unsigned gen = old / nloc;
        if (old + 1u == (gen + 1u) * nloc) {
            __builtin_amdgcn_fence(__ATOMIC_RELEASE, "agent");
            asm volatile("s_waitcnt vmcnt(0)" ::: "memory");
            const unsigned og = xb_add(&bar[XB_TOP], 1u);
            const unsigned tg = og / nx;
            if (og + 1u == (tg + 1u) * nx) xb_add(&bar[XB_TOPGEN], 1u);
            else XB_SPIN(xb_ld(&bar[XB_TOPGEN]) == tg, bar);
            __builtin_amdgcn_fence(__ATOMIC_ACQUIRE, "agent");
            xb_add(&bar[XB_XGEN(b.x)], 1u);
            asm volatile("s_waitcnt vmcnt(0)" ::: "memory");
        } else {
            XB_SPIN(xb_ld(&bar[XB_XGEN(b.x)]) == gen, bar);
            __builtin_amdgcn_fence(__ATOMIC_ACQUIRE, "agent");
            asm volatile("s_waitcnt vmcnt(0)" ::: "memory");
        }
    }
    __syncthreads();
}

#ifndef PROG_LIST
#define PROG_LIST 0,1,2,3,4,5,6,7,8,9,10,11,12,13,14,15,16,17,18,19,20,21,22,23,24
#endif
__constant__ int PROG[] = {PROG_LIST};

__global__ void __launch_bounds__(NTHREADS, 2) fwd_kernel(Params p) {
    extern __shared__ __attribute__((aligned(16))) unsigned char lds_raw[];
    LAS unsigned char* lds = (LAS unsigned char*)lds_raw;
    float* X = (float*)(p.ws + WS_X); bf16_t* H = (bf16_t*)(p.ws + WS_H); bf16_t* ACT = (bf16_t*)(p.ws + WS_PROJ); bf16_t* PROJ = (bf16_t*)(p.ws + WS_PROJ);
    bf16_t* MIX = (bf16_t*)(p.ws + WS_MIX); float* DT = (float*)(p.ws + WS_DT);
    float* PART = (float*)(p.ws + WS_ST);
    const int G = gridDim.x, cblk = blockIdx.x;
    { volatile LAS unsigned* stw = (volatile LAS unsigned*)(lds + 131072); if (threadIdx.x < 4) stw[threadIdx.x] = 0u; }
    __syncthreads();
    const XcdBarrier xbar = xcd_barrier_post((unsigned*)(p.ws + WS_CTL), (volatile LAS unsigned*)(lds + 131072));
    for (int pi = p.ph_lo; pi < p.ph_hi; ++pi) {
        const int ph = PROG[pi];
        if (ph == 0) {
            phase_convert(p, lds_raw);
            phase_norm<0>(p, inp(p, 5), 0, 0.f);
        } else {
            const int layer = (ph - 1) / 12, sub = (ph - 1) % 12;
            unsigned char* wl = p.ws + (size_t)layer * SZ_LAYERW;
            if (sub == 0 || sub == 9) {
                pg8::Gemm g{H, (const bf16_t*)(wl + (sub == 0 ? OFF_WGU1 : OFF_WGU2)), M_ROWS, 11264, H_LD, 2048};
                typedef pg8::SplitOrder<M_ROWS, 11264, 1, 2048> SO; SO S; S.init(G, cblk);
                pg8::EpiSwiglu E{ACT};
                pg8::gemm_phase<pg8::EpiSwiglu, SO, H_LD>(lds, g, S, E);
            } else if (sub == 1 || sub == 10) {
                pg8::Gemm g{ACT, (const bf16_t*)(wl + (sub == 1 ? OFF_WD1 : OFF_WD2)), M_ROWS, 2048, ACT_LD, D_FF};
                typedef pg8::MixedOrder<D_FF, 11> SO; SO S; S.init(G, cblk);
                pg8::EpiAtomic E{X, PART, 0.5f};
                pg8::gemm_phase<pg8::EpiAtomic, SO, ACT_LD>(lds, g, S, E);
            } else if (sub == 7) {
                pg8::Gemm g{MIX, (const bf16_t*)(wl + OFF_WOUT), M_ROWS, 2048, MIX_LD, D_MIX};
                typedef pg8::MixedOrder<D_MIX, 12> SO; SO S; S.init(G, cblk);
                pg8::EpiAtomic E{X, PART, 1.0f};
                pg8::gemm_phase<pg8::EpiAtomic, SO, MIX_LD>(lds, g, S, E);
            } else if (sub == 2 || sub == 8) {
                if (sub == 2) phase_norm<1>(p, inp(p, 9) + (size_t)layer * 2048, 11, 0.5f);
                else phase_norm<1>(p, inp(p, 19) + (size_t)layer * 2048, 12, 1.0f);
            } else if (sub == 3) {
                pg8::Gemm g{H, (const bf16_t*)(wl + OFF_WIN), M_ROWS, N_IN_PAD, H_LD, 2048};
                typedef pg8::SplitOrder<M_ROWS, N_IN_PAD, 1, 2048> SO; SO S; S.init(G, cblk);
                pg8::EpiProj E{PROJ, DT};
                pg8::gemm_phase<pg8::EpiProj, SO, H_LD>(lds, g, S, E);
            } else if (sub == 4) {
                phase_s1(p, layer, lds_raw);
            } else if (sub == 5) {
                phase_s2(p, layer);
            } else if (sub == 6) {
                phase_s3(p, layer, lds_raw);
            } else {
                if (layer == 0) phase_norm<1>(p, inp(p, 5) + 2048, 11, 0.5f);
                else phase_norm<2>(p, inp(p, 23), 11, 0.5f);
            }
        }
        if (pi + 1 < p.ph_hi) {
            if (p.ph_hi > 4096) cg::this_grid().sync();
            xcd_barrier(xbar);
        }
    }
}

#ifndef PROG_LIST
#error
#endif
static const int prog_host[] = {PROG_LIST};
#define NPROG_HOST ((int)(sizeof(prog_host) / sizeof(int)))
extern "C" void kernel_launch(void* const* d_in, const int* in_sizes, int n_in, void* d_out, int out_size, void* d_ws, size_t ws_size, hipStream_t stream) {
    static int grid = 0;
    if (grid == 0) {
        int dev = 0, cus = 0, per_cu = 0;
        hipGetDevice(&dev);
        hipDeviceGetAttribute(&cus, hipDeviceAttributeMultiprocessorCount, dev);
        if (hipFuncSetAttribute((const void*)fwd_kernel, hipFuncAttributeMaxDynamicSharedMemorySize, LDS_BYTES) != hipSuccess) fprintf(stderr, "kernel_launch: hipFuncSetAttribute failed\n");
        if (hipOccupancyMaxActiveBlocksPerMultiprocessor(&per_cu, (const void*)fwd_kernel, NTHREADS, LDS_BYTES) != hipSuccess || per_cu < 1) { fprintf(stderr, "kernel_launch: occupancy query says %d\n", per_cu); per_cu = 1; }
        (void)hipGetLastError();
        if (per_cu > 1) per_cu = 1;
        grid = cus * per_cu;
        if (ws_size < WS_END) fprintf(stderr, "kernel_launch: workspace too small: %zu < %zu\n", ws_size, (size_t)WS_END);
    }
    Params p{};
    for (int i = 0; i < 24; ++i) p.in[i] = (const float*)d_in[i];
    p.out = (float*)d_out; p.ws = (unsigned char*)d_ws;
#if ONE_LAUNCH
    hipMemsetAsync((unsigned char*)d_ws + WS_CTL, 0, 16384, stream);
    p.ph_lo = 0; p.ph_hi = NPROG_HOST;
    void* args[] = {&p};
    hipError_t e = hipLaunchCooperativeKernel((const void*)fwd_kernel, dim3(grid), dim3(NTHREADS), args, LDS_BYTES, stream);
    if (e != hipSuccess) fprintf(stderr, "cooperative launch failed: %s (grid %d)\n", hipGetErrorString(e), grid);
#else
#ifndef PH_LIST
#define PH_LIST 0,1,2,3,4,5,6,7,8,9,10,11,12,13,14,15,16,17,18,19,20,21,22,23,24
#endif
    const int phl[] = {PH_LIST};
    for (int ph : phl) {
        p.ph_lo = ph; p.ph_hi = ph + 1;
        hipLaunchKernelGGL(fwd_kernel, dim3(grid), dim3(NTHREADS), LDS_BYTES, stream, p);
    }
#endif
}
```

```cpp
#include <hip/hip_runtime.h>
#include <hip/hip_cooperative_groups.h>
#include <cstdio>
namespace cg = cooperative_groups;

#ifndef ONE_LAUNCH
#define ONE_LAUNCH 1
#endif

#define LAS __attribute__((address_space(3)))
typedef unsigned short bf16_t;
typedef short bf16x8 __attribute__((ext_vector_type(8)));
typedef float f32x4 __attribute__((ext_vector_type(4)));
typedef float f32x2 __attribute__((ext_vector_type(2)));
typedef unsigned u32x4 __attribute__((ext_vector_type(4)));
typedef unsigned u32x2 __attribute__((ext_vector_type(2)));

constexpr int D_MODEL = 2048, M_ROWS = 8704, NCHUNK = 136, NPCH = 128;
constexpr int D_FF = 5632, PROJ_LD = 9216, N_IN = 9248, N_IN_PAD = 9472, D_MIX = 3072;
constexpr int H_LD = 2048, ACT_LD = D_FF, MIX_LD = D_MIX;
constexpr float EPS = 1e-6f;
constexpr int NTHREADS = 512;
constexpr int LDS_BYTES = 131072 + 16;

constexpr size_t O_SC_P = 17825792, O_CONV_P = 17829888, O_SSM_P = 17854464, O_SC_S = 18378752, O_CONV_S = 18411520, O_SSM_S = 18608128;

constexpr size_t SZ_WGU = (size_t)11264 * H_LD * 2, SZ_WD = (size_t)2048 * ACT_LD * 2, SZ_WIN = (size_t)N_IN_PAD * H_LD * 2, SZ_WOUT = (size_t)2048 * MIX_LD * 2;
constexpr size_t OFF_WGU1 = 0, OFF_WD1 = SZ_WGU, OFF_WIN = SZ_WGU + SZ_WD, OFF_WOUT = OFF_WIN + SZ_WIN, OFF_WGU2 = OFF_WOUT + SZ_WOUT, OFF_WD2 = OFF_WGU2 + SZ_WGU;
constexpr size_t SZ_LAYERW = 2 * SZ_WGU + 2 * SZ_WD + SZ_WIN + SZ_WOUT;
constexpr size_t WS_X = 2 * SZ_LAYERW;
constexpr size_t WS_H = WS_X + (size_t)M_ROWS * 2048 * 4;
constexpr size_t WS_PROJ = WS_H + (size_t)M_ROWS * H_LD * 2;
constexpr size_t WS_MIX = WS_PROJ + (size_t)M_ROWS * PROJ_LD * 2;
constexpr size_t WS_ST = WS_MIX + (size_t)M_ROWS * MIX_LD * 2;
constexpr size_t WS_DT = WS_ST + (size_t)NCHUNK * 32 * 64 * 128 * 2;
constexpr size_t WS_DEC = WS_DT + (size_t)M_ROWS * 32 * 4;
constexpr size_t WS_CTL = WS_DEC + (size_t)NCHUNK * 32 * 4;
constexpr size_t WS_END = WS_CTL + 16384;

struct Params { const float* in[24]; float* out; unsigned char* ws; int ph_lo, ph_hi; };

__device__ __forceinline__ const float* inp(const Params& p, int i) { asm volatile("" : "+s"(i)); return p.in[i]; }
__device__ __forceinline__ float bf_lo(unsigned u) { return __uint_as_float(u << 16); }
__device__ __forceinline__ float bf_hi(unsigned u) { return __uint_as_float(u & 0xffff0000u); }
typedef __bf16 bf16x2v __attribute__((ext_vector_type(2)));
__device__ __forceinline__ unsigned cvt_pk_bf16(float lo, float hi) { f32x2 v = {lo, hi}; bf16x2v b = __builtin_convertvector(v, bf16x2v); return __builtin_bit_cast(unsigned, b); }
__device__ __forceinline__ float silu_f(float x) { return x * __builtin_amdgcn_rcpf(1.f + __expf(-x)); }
__device__ __forceinline__ float softplus_f(float x) { return x > 20.f ? x : log1pf(expf(x)); }
__device__ __forceinline__ int opaque_tid() { int t = threadIdx.x; asm volatile("" : "+v"(t)); return t; }
__device__ __forceinline__ float bfv(const u32x4& v, int j) { const unsigned w = v[j >> 1]; return (j & 1) ? bf_hi(w) : bf_lo(w); }

namespace pg8 {
constexpr int BM = 256, BK = 64, HALF = 128, HTB = HALF * BK * 2, STAGE_BYTES = 8 * HTB, NXCD = 8, WGM = 8;
__host__ __device__ __forceinline__ int lds_byte(int r, int c) { const int st = (r >> 4) * 2 + (c >> 5), rr = r & 15, cc = c & 31, ob = rr * 64 + cc * 2; return st * 1024 + (ob ^ (((ob >> 9) & 1) << 5)); }
__host__ __device__ __forceinline__ void stage_rc(int b, int& R, int& C) { const int st = b / 1024, sb = b % 1024, swz = sb ^ (((sb >> 9) & 1) << 5); R = (st >> 1) * 16 + swz / 64; C = (st & 1) * 32 + (swz % 64) / 2; }
__host__ __device__ __forceinline__ int perm32(int rho) { const int n = rho >> 4, i = rho & 15; return 8 * (i >> 2) + 4 * n + (i & 3); }

__host__ __device__ __forceinline__ int perm32_inv(int s) { return 16 * ((s >> 2) & 1) + 4 * (s >> 3) + (s & 3); }
__device__ __forceinline__ size_t img_off(int row, int col, int KT) {
    return ((size_t)((row >> 8) * KT + (col >> 6)) << 14) + (size_t)(((row >> 7) & 1) << 13) + (size_t)(lds_byte(row & 127, col & 63) >> 1);
}
struct Unit { int pm, pn, kofs, nt, part; };
struct Gemm { const bf16_t* A; const bf16_t* Bt; int M, N, ld, Kc; };

template <int M, int N, int KS, int Kc>
struct SplitOrder {
    static constexpr int nM = M / BM, nN = N / BM, nwg = nM * nN;
    int G, c;
    __device__ void init(int G_, int c_) { G = G_; c = c_; }
    __device__ bool next(int i, Unit& u) const {
        const int L = i * G + c; if (L >= nwg * KS) return false;
        const int ks = L / nwg; int wgid = L - ks * nwg;
        { const int q = nwg / NXCD, r = nwg % NXCD, xcd = wgid % NXCD, off = wgid / NXCD; wgid = (xcd < r ? xcd * (q + 1) : r * (q + 1) + (xcd - r) * q) + off; }
        const int nig = WGM * nN, gid = wgid / nig, fm = gid * WGM, gsz = (nM - fm) < WGM ? (nM - fm) : WGM;
        u.pm = fm + ((wgid % nig) % gsz); u.pn = (wgid % nig) / gsz; u.kofs = ks * Kc; u.nt = Kc / BK; u.part = -1; return true;
    }
};


template <int K, int KS>
struct MixedOrder {
    static constexpr int nFull = 256, KcP = K / KS;
    int G, c;
    __device__ void init(int G_, int c_) { G = G_; c = c_; }
    __device__ bool next(int i, Unit& u) const {
        const int L = i * G + c;
        if (L < nFull) {
            int wgid = L; { const int q = nFull / NXCD, xcd = wgid % NXCD, off = wgid / NXCD; wgid = xcd * q + off; }
            const int nig = WGM * 8, gid = wgid / nig, fm = gid * WGM;
            u.pm = fm + ((wgid % nig) % WGM); u.pn = (wgid % nig) / WGM; u.kofs = 0; u.nt = K / BK; u.part = -1; return true;
        }
        const int q = L - nFull; if (q >= 16 * KS) return false;
        const int tile = q / KS, ks = q - tile * KS;
        u.pm = 32 + (tile >> 3); u.pn = tile & 7; u.kofs = ks * KcP; u.nt = KcP / BK; u.part = ks; return true;
    }
};

struct EpiSwiglu {
    static constexpr bool PERM = true;
    bf16_t* O;
    __device__ __forceinline__ void operator()(const f32x4 (&acc)[2][2][4][2], const Unit& u, int wr, int wc, int fr, int fq) const {
        const int row0 = u.pm * BM + wr * 64 + fr, col0 = u.pn * 128 + wc * 32 + 8 * fq;
#pragma unroll
        for (int ai = 0; ai < 2; ++ai)
#pragma unroll
            for (int m = 0; m < 4; ++m) {
                bf16_t* rowp = O + img_off(row0 + ai * HALF + m * 16, col0, D_FF / 64);
                const f32x4 g0 = acc[ai][0][m][0], g1 = acc[ai][0][m][1], u0 = acc[ai][1][m][0], u1 = acc[ai][1][m][1];
                u32x4 w;
                w.x = cvt_pk_bf16(silu_f(g0[0]) * u0[0], silu_f(g0[1]) * u0[1]); w.y = cvt_pk_bf16(silu_f(g0[2]) * u0[2], silu_f(g0[3]) * u0[3]);
                w.z = cvt_pk_bf16(silu_f(g1[0]) * u1[0], silu_f(g1[1]) * u1[1]); w.w = cvt_pk_bf16(silu_f(g1[2]) * u1[2], silu_f(g1[3]) * u1[3]);
                *(u32x4*)rowp = w;
            }
    }
};
struct EpiAtomic {
    static constexpr bool PERM = false;
    float* X; float* PART; float scale;
    __device__ __forceinline__ void operator()(const f32x4 (&acc)[2][2][4][2], const Unit& u, int wr, int wc, int fr, int fq) const {
        const int row0 = u.pm * BM + wr * 64 + fr, col0 = u.pn * BM + wc * 32 + 4 * fq;
        if (u.part < 0) {
#pragma unroll
            for (int ai = 0; ai < 2; ++ai)
#pragma unroll
                for (int m = 0; m < 4; ++m) {
                    float* rowp = X + (size_t)(row0 + ai * HALF + m * 16) * D_MODEL + col0;
                    f32x4 xv[2][2];
#pragma unroll
                    for (int bj = 0; bj < 2; ++bj)
#pragma unroll
                        for (int n = 0; n < 2; ++n) xv[bj][n] = *(const f32x4*)(rowp + bj * HALF + n * 16);
#pragma unroll
                    for (int bj = 0; bj < 2; ++bj)
#pragma unroll
                        for (int n = 0; n < 2; ++n) *(f32x4*)(rowp + bj * HALF + n * 16) = xv[bj][n] + scale * acc[ai][bj][m][n];
                }
        } else {
            float* base = PART + (size_t)u.part * (512 * 2048);
#pragma unroll
            for (int ai = 0; ai < 2; ++ai)
#pragma unroll
                for (int m = 0; m < 4; ++m) {
                    float* rowp = base + (size_t)(row0 - 8192 + ai * HALF + m * 16) * D_MODEL + col0;
#pragma unroll
                    for (int bj = 0; bj < 2; ++bj)
#pragma unroll
                        for (int n = 0; n < 2; ++n) *(f32x4*)(rowp + bj * HALF + n * 16) = acc[ai][bj][m][n];
                }
        }
    }
};
struct EpiProj {
    static constexpr bool PERM = true;
    bf16_t* P; float* DT;
    __device__ __forceinline__ void operator()(const f32x4 (&acc)[2][2][4][2], const Unit& u, int wr, int wc, int fr, int fq) const {
        const int row0 = u.pm * BM + wr * 64 + fr;
        if (u.pn < 36) {
            const int col0 = u.pn * BM + wc * 32 + 8 * fq;
#pragma unroll
            for (int ai = 0; ai < 2; ++ai)
#pragma unroll
                for (int m = 0; m < 4; ++m) {
                    bf16_t* rowp = P + (size_t)(row0 + ai * HALF + m * 16) * PROJ_LD + col0;
#pragma unroll
                    for (int bj = 0; bj < 2; ++bj) {
                        const f32x4 v0 = acc[ai][bj][m][0], v1 = acc[ai][bj][m][1];
                        u32x4 w; w.x = cvt_pk_bf16(v0[0], v0[1]); w.y = cvt_pk_bf16(v0[2], v0[3]); w.z = cvt_pk_bf16(v1[0], v1[1]); w.w = cvt_pk_bf16(v1[2], v1[3]);
                        *(u32x4*)(rowp + bj * HALF) = w;
                    }
                }
        } else if (wc == 0) {
#pragma unroll
            for (int ai = 0; ai < 2; ++ai)
#pragma unroll
                for (int m = 0; m < 4; ++m) {
                    float* rowp = DT + (size_t)(row0 + ai * HALF + m * 16) * 32 + 8 * fq;
                    *(f32x4*)rowp = acc[ai][0][m][0]; *(f32x4*)(rowp + 4) = acc[ai][0][m][1];
                }
        }
    }
};

template <class Epi, class Sched, int LD>
__device__ __forceinline__ void gemm_phase(LAS unsigned char* lds, const Gemm g, const Sched& S, const Epi& E) {
    const int tid = opaque_tid(), wid = __builtin_amdgcn_readfirstlane(tid >> 6), lane = tid & 63, wr = wid >> 2, wc = wid & 3, fr = lane & 15, fq = lane >> 4;
    constexpr int K = LD;
    unsigned voffA[2], voffB[2];
#pragma unroll
    for (int i = 0; i < 2; ++i) { voffA[i] = (unsigned)(tid * 16 + i * 8192); voffB[i] = voffA[i]; }
    const size_t kstep = (size_t)(2 * HTB);
    const size_t hstep = (size_t)HTB;
    const size_t tstep = (size_t)(K / BK) * kstep;
    const unsigned ldsw = (unsigned)wid * 1024u;
    const int aoff = lds_byte(wr * 64 + fr, fq * 8), boff = lds_byte(wc * 32 + fr, fq * 8);
#define PG8_SA(b, h) (((b) * 2 + (h)) * HTB)
#define PG8_SB(b, h) ((4 + (b) * 2 + (h)) * HTB)
#define PG8_STAGE(bufoff, gbase, voff) do { _Pragma("unroll") for (int _i = 0; _i < 2; ++_i) \
        __builtin_amdgcn_global_load_lds((const unsigned*)((const char*)(gbase) + (voff)[_i]), (LAS unsigned*)(lds + (bufoff) + ldsw + _i * 8192), 16, 0, 0); } while (0)
#define PG8_LDA(dst, b, h) do { _Pragma("unroll") for (int m = 0; m < 4; ++m) _Pragma("unroll") for (int k = 0; k < 2; ++k) dst[m][k] = *(const LAS bf16x8*)(lds + PG8_SA(b, h) + aoff + m * 2048 + k * 1024); } while (0)
#define PG8_LDB(dst, b, h) do { _Pragma("unroll") for (int n = 0; n < 2; ++n) _Pragma("unroll") for (int k = 0; k < 2; ++k) dst[n][k] = *(const LAS bf16x8*)(lds + PG8_SB(b, h) + boff + n * 2048 + k * 1024); } while (0)
#define PG8_MMA(ai, bj, At, Bt) do { __builtin_amdgcn_s_setprio(1); _Pragma("unroll") for (int m = 0; m < 4; ++m) _Pragma("unroll") for (int n = 0; n < 2; ++n) _Pragma("unroll") for (int k = 0; k < 2; ++k) \
        acc[ai][bj][m][n] = __builtin_amdgcn_mfma_f32_16x16x32_bf16(Bt[n][k], At[m][k], acc[ai][bj][m][n], 0, 0, 0); __builtin_amdgcn_s_setprio(0); } while (0)
#define PG8_WAIT_V(n) asm volatile("s_waitcnt vmcnt(" #n ")" ::: "memory")
#define PG8_WAIT_L(n) asm volatile("s_waitcnt lgkmcnt(" #n ")" ::: "memory")
#define PG8_BAR __builtin_amdgcn_s_barrier()
#define PG8_SCHED __builtin_amdgcn_sched_barrier(0)
    Unit cur, nxt; int ui = 0;
    if (!S.next(0, cur)) return;
    f32x4 acc[2][2][4][2];
#pragma unroll
    for (int a = 0; a < 2; ++a)
#pragma unroll
        for (int b = 0; b < 2; ++b)
#pragma unroll
            for (int m = 0; m < 4; ++m)
#pragma unroll
                for (int n = 0; n < 2; ++n) acc[a][b][m][n] = (f32x4){0.f, 0.f, 0.f, 0.f};
    bf16x8 At[4][2], B0[2][2], B1[2][2];
    const char* cA = (const char*)g.A + (size_t)cur.pm * tstep + (size_t)(cur.kofs / BK) * kstep; const char* cB = (const char*)g.Bt + (size_t)cur.pn * tstep + (size_t)(cur.kofs / BK) * kstep;
    PG8_STAGE(PG8_SB(0, 0), cB, voffB); PG8_STAGE(PG8_SA(0, 0), cA, voffA); PG8_STAGE(PG8_SB(0, 1), cB + hstep, voffB); PG8_STAGE(PG8_SA(0, 1), cA + hstep, voffA);
    if (wr == 1) PG8_BAR;
    PG8_WAIT_V(4); PG8_BAR;
    PG8_STAGE(PG8_SB(1, 0), cB + kstep, voffB); PG8_STAGE(PG8_SA(1, 0), cA + kstep, voffA); PG8_STAGE(PG8_SB(1, 1), cB + hstep + kstep, voffB);
    PG8_WAIT_V(6); PG8_BAR;
    for (;;) {
        const bool has_next = S.next(ui + 1, nxt);
        const char* nA = has_next ? (const char*)g.A + (size_t)nxt.pm * tstep + (size_t)(nxt.kofs / BK) * kstep : cA; const char* nB = has_next ? (const char*)g.Bt + (size_t)nxt.pn * tstep + (size_t)(nxt.kofs / BK) * kstep : cB;
        const int nt = cur.nt;
        for (int t = 0; t < nt; t += 2) {
            const bool last = (t == nt - 2);
            const char* a1 = cA + (size_t)(t + 1) * kstep;
            const char* a2 = last ? nA : cA + (size_t)(t + 2) * kstep; const char* b2 = last ? nB : cB + (size_t)(t + 2) * kstep;
            const char* a3 = a2 + kstep; const char* b3 = b2 + kstep;
            PG8_LDB(B0, 0, 0); PG8_SCHED; PG8_LDA(At, 0, 0); PG8_STAGE(PG8_SA(1, 1), a1 + hstep, voffA);
            PG8_WAIT_L(8); PG8_BAR; PG8_WAIT_L(0); PG8_MMA(0, 0, At, B0); PG8_BAR; PG8_SCHED;
            PG8_LDB(B1, 0, 1); PG8_STAGE(PG8_SB(0, 0), b2, voffB);
            PG8_BAR; PG8_WAIT_L(0); PG8_MMA(0, 1, At, B1); PG8_BAR;
            PG8_LDA(At, 0, 1); PG8_STAGE(PG8_SA(0, 0), a2, voffA);
            PG8_BAR; PG8_WAIT_L(0); PG8_MMA(1, 0, At, B0); PG8_BAR; PG8_SCHED;
            PG8_STAGE(PG8_SB(0, 1), b2 + hstep, voffB);
            PG8_WAIT_V(6); PG8_BAR; PG8_MMA(1, 1, At, B1); PG8_BAR;
            PG8_LDB(B0, 1, 0); PG8_SCHED; PG8_LDA(At, 1, 0); PG8_STAGE(PG8_SA(0, 1), a2 + hstep, voffA);
            PG8_WAIT_L(8); PG8_BAR; PG8_WAIT_L(0); PG8_MMA(0, 0, At, B0); PG8_BAR; PG8_SCHED;
            PG8_LDB(B1, 1, 1); PG8_STAGE(PG8_SB(1, 0), b3, voffB);
            PG8_BAR; PG8_WAIT_L(0); PG8_MMA(0, 1, At, B1); PG8_BAR;
            PG8_LDA(At, 1, 1); PG8_STAGE(PG8_SA(1, 0), a3, voffA);
            PG8_BAR; PG8_WAIT_L(0); PG8_MMA(1, 0, At, B0); PG8_BAR; PG8_SCHED;
            PG8_STAGE(PG8_SB(1, 1), b3 + hstep, voffB);
            PG8_WAIT_V(6); PG8_BAR; PG8_MMA(1, 1, At, B1); PG8_BAR;
        }
        E(acc, cur, wr, wc, fr, fq);
        if (!has_next) break;
#pragma unroll
        for (int a = 0; a < 2; ++a)
#pragma unroll
            for (int b = 0; b < 2; ++b)
#pragma unroll
                for (int m = 0; m < 4; ++m)
#pragma unroll
                    for (int n = 0; n < 2; ++n) acc[a][b][m][n] = (f32x4){0.f, 0.f, 0.f, 0.f};
        cur = nxt; cA = nA; cB = nB; ++ui;
    }
    PG8_WAIT_V(0);
    if (wr == 0) PG8_BAR;
    PG8_BAR;
#undef PG8_SA
#undef PG8_SB
#undef PG8_STAGE
#undef PG8_LDA
#undef PG8_LDB
#undef PG8_MMA
#undef PG8_WAIT_V
#undef PG8_WAIT_L
#undef PG8_BAR
#undef PG8_SCHED
}
}

struct TileInfo { const float* src; bf16_t* dst; int K, N, k0, n0, mode, perm; };
constexpr int CONV_TILES_LAYER = 6 * 352 + 580 + 192;

__device__ __forceinline__ void conv_decode(const Params& p, int t, TileInfo& ti) {
    const int layer = t / CONV_TILES_LAYER; int r = t % CONV_TILES_LAYER;
    unsigned char* wl = p.ws + (size_t)layer * SZ_LAYERW;
    int ntn;
    if (r < 352)       { ti.src = inp(p, 6)  + (size_t)layer * 2048 * 5632; ti.dst = (bf16_t*)(wl + OFF_WGU1); ti.K = 2048; ti.N = 5632; ti.mode = 1; ti.perm = 1; ntn = 88; }
    else if (r < 704)  { r -= 352;  ti.src = inp(p, 7)  + (size_t)layer * 2048 * 5632; ti.dst = (bf16_t*)(wl + OFF_WGU1); ti.K = 2048; ti.N = 5632; ti.mode = 2; ti.perm = 1; ntn = 88; }
    else if (r < 1056) { r -= 704;  ti.src = inp(p, 8)  + (size_t)layer * 5632 * 2048; ti.dst = (bf16_t*)(wl + OFF_WD1);  ti.K = 5632; ti.N = 2048; ti.mode = 0; ti.perm = 0; ntn = 32; }
    else if (r < 1636) { r -= 1056; ti.src = inp(p, 10) + (size_t)layer * 2048 * N_IN; ti.dst = (bf16_t*)(wl + OFF_WIN);  ti.K = 2048; ti.N = N_IN; ti.mode = 0; ti.perm = 1; ntn = 145; }
    else if (r < 1828) { r -= 1636; ti.src = inp(p, 18) + (size_t)layer * 3072 * 2048; ti.dst = (bf16_t*)(wl + OFF_WOUT); ti.K = 3072; ti.N = 2048; ti.mode = 0; ti.perm = 0; ntn = 32; }
    else if (r < 2180) { r -= 1828; ti.src = inp(p, 20) + (size_t)layer * 2048 * 5632; ti.dst = (bf16_t*)(wl + OFF_WGU2); ti.K = 2048; ti.N = 5632; ti.mode = 1; ti.perm = 1; ntn = 88; }
    else if (r < 2532) { r -= 2180; ti.src = inp(p, 21) + (size_t)layer * 2048 * 5632; ti.dst = (bf16_t*)(wl + OFF_WGU2); ti.K = 2048; ti.N = 5632; ti.mode = 2; ti.perm = 1; ntn = 88; }
    else               { r -= 2532; ti.src = inp(p, 22) + (size_t)layer * 5632 * 2048; ti.dst = (bf16_t*)(wl + OFF_WD2);  ti.K = 5632; ti.N = 2048; ti.mode = 0; ti.perm = 0; ntn = 32; }
    ti.k0 = (r / ntn) * 512; ti.n0 = (r % ntn) * 64;
}
__device__ __forceinline__ void conv_load(const TileInfo& ti, f32x4 (&r)[16], int tid) {
    const int lane = tid & 63, wave = tid >> 6, n = ti.n0 + (lane & 15) * 4, k = ti.k0 + wave * 64 + (lane >> 4) * 16;
#pragma unroll
    for (int i = 0; i < 16; ++i) {
        if (n < ti.N) r[i] = __builtin_nontemporal_load((const f32x4*)(ti.src + (size_t)(k + i) * ti.N + n));
        else r[i] = (f32x4){0.f, 0.f, 0.f, 0.f};
    }
}
constexpr int DEF_TILES = 996, DEF_G1A = 0, DEF_G1B = 240, DEF_G3 = 480, DEF_S1 = 612, DEF_S3 = 804;
__device__ __forceinline__ int conv_tile_id(int t, bool deferred) { return (deferred && t >= CONV_TILES_LAYER) ? t + DEF_TILES : t; }

__device__ __forceinline__ void convert_tiles(const Params& p, int tid, int first, int stride, int count, bool phase0, bool deferred) {
    f32x4 r[16], rn[16];
    if (count > 0) { TileInfo t0; conv_decode(p, phase0 ? conv_tile_id(first, deferred) : first, t0); conv_load(t0, r, tid); }
    for (int i = 0; i < count; ++i) {
        const int t = first + i * stride;
        if (i + 1 < count) { TileInfo tin; conv_decode(p, phase0 ? conv_tile_id(t + stride, deferred) : t + stride, tin); conv_load(tin, rn, tid); }
        {
            TileInfo ti; conv_decode(p, phase0 ? conv_tile_id(t, deferred) : t, ti);
            const int lane = tid & 63, wave = tid >> 6, n = ti.n0 + (lane & 15) * 4, k = ti.k0 + wave * 64 + (lane >> 4) * 16;
            if (n < ti.N) {
#pragma unroll
                for (int j = 0; j < 4; ++j) {
                    u32x4 w0, w1;
                    w0.x = cvt_pk_bf16(r[0][j], r[1][j]);  w0.y = cvt_pk_bf16(r[2][j], r[3][j]);   w0.z = cvt_pk_bf16(r[4][j], r[5][j]);   w0.w = cvt_pk_bf16(r[6][j], r[7][j]);
                    w1.x = cvt_pk_bf16(r[8][j], r[9][j]);  w1.y = cvt_pk_bf16(r[10][j], r[11][j]); w1.z = cvt_pk_bf16(r[12][j], r[13][j]); w1.w = cvt_pk_bf16(r[14][j], r[15][j]);
                    const int nn = n + j;
                    int row = nn;
                    if (ti.mode == 1) row = (nn >> 7) * 256 + (nn & 127);
                    else if (ti.mode == 2) row = (nn >> 7) * 256 + 128 + (nn & 127);
                    if (ti.perm) row = (row & ~31) + pg8::perm32_inv(row & 31);
                    *(u32x4*)(ti.dst + pg8::img_off(row, k, ti.K >> 6)) = w0; *(u32x4*)(ti.dst + pg8::img_off(row, k + 8, ti.K >> 6)) = w1;
                }
            }
        }
#pragma unroll
        for (int i2 = 0; i2 < 16; ++i2) r[i2] = rn[i2];
    }
}
__device__ __forceinline__ void convert_deferred(const Params& p, int l1_first, int count) {
    int f = CONV_TILES_LAYER + l1_first; asm volatile("" : "+s"(f));
    convert_tiles(p, opaque_tid(), f, 1, count, false, true);
}
__device__ void phase_convert(const Params& p, unsigned char* lds_raw) {
    const int tid = opaque_tid();
    const bool deferred = (gridDim.x == 256);
    const int total = deferred ? 2 * CONV_TILES_LAYER - DEF_TILES : 2 * CONV_TILES_LAYER;
    int t = blockIdx.x; asm volatile("" : "+s"(t));
    const int count = (t < total) ? (total - t + (int)gridDim.x - 1) / (int)gridDim.x : 0;
    convert_tiles(p, tid, t, gridDim.x, count, true, deferred);
    for (int layer = 0; layer < 2; ++layer) {
        bf16_t* wz = (bf16_t*)(p.ws + (size_t)layer * SZ_LAYERW + OFF_WIN);
        for (int i = blockIdx.x * NTHREADS + tid; i < (N_IN_PAD - N_IN) * 256; i += gridDim.x * NTHREADS)
            *(u32x4*)(wz + pg8::img_off(N_IN + (i >> 8), (i & 255) * 8, 32)) = (u32x4){0u, 0u, 0u, 0u};
    }
}

template <int MODE>
__device__ __forceinline__ void norm_row(const Params& p, const f32x4 (&g)[8], int r, int lane, int nparts, float pscale) {
    float* X = (float*)(p.ws + WS_X); bf16_t* H = (bf16_t*)(p.ws + WS_H);
    const float* src = (MODE == 0) ? (r < 8192 ? inp(p, 0) + (size_t)r * 2048 : inp(p, 1) + (size_t)(r - 8192) * 2048) : X + (size_t)r * 2048;
    f32x4 v[8]; float ss = 0.f;
#pragma unroll
    for (int i = 0; i < 8; ++i) v[i] = *(const f32x4*)(src + i * 256 + lane * 4);
    if (MODE != 0 && nparts > 0 && r >= 8192) {
        const float* pp = (const float*)(p.ws + WS_ST) + (size_t)(r - 8192) * 2048 + lane * 4;
        f32x4 a[8];
#pragma unroll
        for (int i = 0; i < 8; ++i) a[i] = (f32x4){0.f, 0.f, 0.f, 0.f};
        for (int k = 0; k < nparts; ++k) {
#pragma unroll
            for (int i = 0; i < 8; ++i) a[i] += *(const f32x4*)(pp + (size_t)k * (512 * 2048) + i * 256);
        }
#pragma unroll
        for (int i = 0; i < 8; ++i) { v[i] += pscale * a[i]; *(f32x4*)(X + (size_t)r * 2048 + i * 256 + lane * 4) = v[i]; }
    }
#pragma unroll
    for (int i = 0; i < 8; ++i) ss += v[i][0] * v[i][0] + v[i][1] * v[i][1] + v[i][2] * v[i][2] + v[i][3] * v[i][3];
#pragma unroll
    for (int o = 32; o >= 1; o >>= 1) ss += __shfl_xor(ss, o);
    const float rstd = rsqrtf(ss * (1.f / 2048.f) + EPS);
#pragma unroll
    for (int i = 0; i < 8; ++i) {
        if (MODE == 0) *(f32x4*)(X + (size_t)r * 2048 + i * 256 + lane * 4) = v[i];
        const f32x4 o = v[i] * rstd * g[i];
        if (MODE < 2) { u32x2 w; w.x = cvt_pk_bf16(o[0], o[1]); w.y = cvt_pk_bf16(o[2], o[3]); *(u32x2*)(H + pg8::img_off(r, i * 256 + lane * 4, 32)) = w; }
        else *(f32x4*)(p.out + (size_t)r * 2048 + i * 256 + lane * 4) = o;
    }
}
template <int MODE>
__device__ void phase_norm(const Params& p, const float* gamma, int nparts, float pscale) {
    const int tid = opaque_tid(), lane = tid & 63, wave = tid >> 6;
    f32x4 g[8];
#pragma unroll
    for (int i = 0; i < 8; ++i) g[i] = *(const f32x4*)(gamma + i * 256 + lane * 4);
    if (wave < 2) for (int s = blockIdx.x * 2 + wave; s < 512; s += gridDim.x * 2) norm_row<MODE>(p, g, 8192 + s, lane, nparts, pscale);
    for (int r = blockIdx.x * 8 + wave; r < 8192; r += gridDim.x * 8) norm_row<MODE>(p, g, r, lane, nparts, pscale);
}

__device__ __forceinline__ u32x4 fetch_xbc8(const bf16_t* proj, const float* hist, int c, int lrow, int col) {
    if (lrow >= 0 || (c > 0 && c < NPCH)) return *(const u32x4*)(proj + (size_t)(c * 64 + lrow) * PROJ_LD + 5120 + col);
    if (c == 0) return (u32x4){0u, 0u, 0u, 0u};
    const float* h = hist + ((size_t)(c - NPCH) * 3 + (3 + lrow)) * 4096 + col;
    const f32x4 a = *(const f32x4*)h, b = *(const f32x4*)(h + 4);
    u32x4 w; w.x = cvt_pk_bf16(a[0], a[1]); w.y = cvt_pk_bf16(a[2], a[3]); w.z = cvt_pk_bf16(b[0], b[1]); w.w = cvt_pk_bf16(b[2], b[3]);
    return w;
}
__device__ __forceinline__ void dt_acum(const Params& p, int layer, int c, int h, int lane, float& dtv, float& acum, float& total) {
    const float* DT = (const float*)(p.ws + WS_DT);
    const float raw = DT[(size_t)(c * 64 + lane) * 32 + h];
    dtv = softplus_f(raw + inp(p, 14)[layer * 32 + h]);
    const float A = -expf(inp(p, 15)[layer * 32 + h]);
    float a = dtv * A;
#pragma unroll
    for (int o = 1; o < 64; o <<= 1) { const float t = __shfl_up(a, o); if (lane >= o) a += t; }
    acum = a; total = __shfl(a, 63);
}

__device__ void phase_s1(const Params& p, int layer, unsigned char* lds) {
    bf16_t* s_xwT = (bf16_t*)lds;
    bf16_t* s_BT = (bf16_t*)(lds + 36864);
    float* s_w = (float*)(lds + 55296);
    const int tid = opaque_tid(), lane = tid & 63, wave = tid >> 6, fr = lane & 15, fq = lane >> 4;
    const bf16_t* proj = (const bf16_t*)(p.ws + WS_PROJ);
    bf16_t* mix = (bf16_t*)(p.ws + WS_MIX);
    bf16_t* ST = (bf16_t*)(p.ws + WS_ST);
    float* DEC = (float*)(p.ws + WS_DEC);
    const float* hist = inp(p, 3) + (size_t)layer * 8 * 3 * 4096;
    for (int unit = blockIdx.x; unit < NCHUNK * 8; unit += gridDim.x) {
        const int c = unit >> 3, g = unit & 7, row0 = c * 64;
        const bool last_chunk = (c >= NPCH - 1);
        if (wave < 4) {
            const int h = g * 4 + wave; float dtv, acum, total;
            dt_acum(p, layer, c, h, lane, dtv, acum, total);
            s_w[wave * 64 + lane] = dtv * __expf(total - acum);
            if (lane == 0) DEC[c * 32 + h] = __expf(total);
        }
        __syncthreads();
        if (tid < 384) {
            const int rr = tid & 7, cg = tid >> 3, l0 = rr * 8;
            const int col = (cg < 32) ? g * 256 + cg * 8 : 2048 + g * 128 + (cg - 32) * 8;
            u32x4 rows[11];
#pragma unroll
            for (int i = 0; i < 11; ++i) rows[i] = fetch_xbc8(proj, hist, c, l0 - 3 + i, col);
            const float* cw = inp(p, 12) + (size_t)layer * 4 * 4096 + col; const float* cb = inp(p, 13) + (size_t)layer * 4096 + col;
            float w[4][8], b[8];
#pragma unroll
            for (int k = 0; k < 4; ++k) { const f32x4 a = *(const f32x4*)(cw + k * 4096), bb = *(const f32x4*)(cw + k * 4096 + 4);
#pragma unroll
                for (int j = 0; j < 4; ++j) { w[k][j] = a[j]; w[k][4 + j] = bb[j]; } }
            { const f32x4 a = *(const f32x4*)cb, bb = *(const f32x4*)(cb + 4);
#pragma unroll
              for (int j = 0; j < 4; ++j) { b[j] = a[j]; b[4 + j] = bb[j]; } }
            float sc[8];
#pragma unroll
            for (int i = 0; i < 8; ++i) sc[i] = (cg < 32) ? s_w[(cg >> 3) * 64 + l0 + i] : 1.f;
            bf16_t* dstT = (cg < 32) ? s_xwT + (cg * 8) * 72 + l0 : s_BT + ((cg - 32) * 8) * 72 + l0;
#pragma unroll
            for (int j = 0; j < 8; ++j) {
                float o[8];
#pragma unroll
                for (int i = 0; i < 8; ++i) {
                    float v = b[j];
#pragma unroll
                    for (int k = 0; k < 4; ++k) v += w[k][j] * bfv(rows[i + k], j);
                    o[i] = silu_f(v) * sc[i];
                }
                u32x4 pk; pk.x = cvt_pk_bf16(o[0], o[1]); pk.y = cvt_pk_bf16(o[2], o[3]); pk.z = cvt_pk_bf16(o[4], o[5]); pk.w = cvt_pk_bf16(o[6], o[7]);
                *(u32x4*)(dstT + j * 72) = pk;
            }
        } else {
            const int t2 = tid - 384, rr = t2 & 7, cgi = t2 >> 3, l0 = rr * 8, ch0 = g * 128 + cgi * 8;
            const float* scw = inp(p, 11) + (size_t)layer * 3 * 1024 + ch0;
            float w[3][8];
#pragma unroll
            for (int k = 0; k < 3; ++k) { const f32x4 a = *(const f32x4*)(scw + k * 1024), bb = *(const f32x4*)(scw + k * 1024 + 4);
#pragma unroll
                for (int j = 0; j < 4; ++j) { w[k][j] = a[j]; w[k][4 + j] = bb[j]; } }
            float um2[8], um1[8], u0[8];
#pragma unroll
            for (int i = 0; i < 10; ++i) {
                const int lrow = l0 - 2 + i;
#pragma unroll
                for (int j = 0; j < 8; ++j) { um2[j] = um1[j]; um1[j] = u0[j]; }
                if (lrow >= 0 || (c > 0 && c < NPCH)) {
                    const bf16_t* rp = proj + (size_t)(row0 + lrow) * PROJ_LD + ch0;
                    const u32x4 cv = *(const u32x4*)(rp + 1024), xv = *(const u32x4*)(rp + 2048);
#pragma unroll
                    for (int j = 0; j < 8; ++j) u0[j] = bfv(cv, j) * bfv(xv, j);
                } else if (c == 0) {
#pragma unroll
                    for (int j = 0; j < 8; ++j) u0[j] = 0.f;
                } else {
                    const float* hp = inp(p, 2) + (((size_t)layer * 8 + (c - NPCH)) * 2 + (2 + lrow)) * 1024 + ch0;
                    const f32x4 a = *(const f32x4*)hp, bb = *(const f32x4*)(hp + 4);
#pragma unroll
                    for (int j = 0; j < 4; ++j) { u0[j] = a[j]; u0[4 + j] = bb[j]; }
                }
                if (i >= 2) {
                    const int l = l0 + i - 2;
                    const u32x4 bv = *(const u32x4*)(proj + (size_t)(row0 + l) * PROJ_LD + ch0);
                    float y[8];
#pragma unroll
                    for (int j = 0; j < 8; ++j) y[j] = bfv(bv, j) * (w[0][j] * um2[j] + w[1][j] * um1[j] + w[2][j] * u0[j]);
                    u32x4 pk; pk.x = cvt_pk_bf16(y[0], y[1]); pk.y = cvt_pk_bf16(y[2], y[3]); pk.z = cvt_pk_bf16(y[4], y[5]); pk.w = cvt_pk_bf16(y[6], y[7]);
                    *(u32x4*)(mix + pg8::img_off(row0 + l, ch0, D_MIX / 64)) = pk;
                    if (last_chunk && l >= 62) {
                        float* op = (c < NPCH) ? p.out + O_SC_P + ((size_t)layer * 2 + (l - 62)) * 1024 + ch0
                                               : p.out + O_SC_S + (((size_t)layer * 8 + (c - NPCH)) * 2 + (l - 62)) * 1024 + ch0;
                        *(f32x4*)op = (f32x4){u0[0], u0[1], u0[2], u0[3]}; *(f32x4*)(op + 4) = (f32x4){u0[4], u0[5], u0[6], u0[7]};
                    }
                }
            }
        }
        __syncthreads();
        {
            const int hh = wave >> 1, half = wave & 1, h = g * 4 + hh;
            f32x4 acc[4][4];
#pragma unroll
            for (int a = 0; a < 4; ++a)
#pragma unroll
                for (int b = 0; b < 4; ++b) acc[a][b] = (f32x4){0.f, 0.f, 0.f, 0.f};
#pragma unroll
            for (int ks = 0; ks < 2; ++ks) {
                bf16x8 af[4], bfr[4];
#pragma unroll
                for (int a = 0; a < 4; ++a) af[a] = *(const bf16x8*)(s_BT + (half * 64 + a * 16 + fr) * 72 + ks * 32 + fq * 8);
#pragma unroll
                for (int b = 0; b < 4; ++b) bfr[b] = *(const bf16x8*)(s_xwT + (hh * 64 + b * 16 + fr) * 72 + ks * 32 + fq * 8);
#pragma unroll
                for (int a = 0; a < 4; ++a)
#pragma unroll
                    for (int b = 0; b < 4; ++b) acc[a][b] = __builtin_amdgcn_mfma_f32_16x16x32_bf16(af[a], bfr[b], acc[a][b], 0, 0, 0);
            }
            bf16_t* stp = ST + ((size_t)(c * 32 + h) * 64) * 128;
#pragma unroll
            for (int a = 0; a < 4; ++a)
#pragma unroll
                for (int b = 0; b < 4; ++b) {
                    u32x2 w; w.x = cvt_pk_bf16(acc[a][b][0], acc[a][b][1]); w.y = cvt_pk_bf16(acc[a][b][2], acc[a][b][3]);
                    *(u32x2*)(stp + (size_t)(b * 16 + fr) * 128 + half * 64 + a * 16 + fq * 4) = w;
                }
        }
        __syncthreads();
    }
}

__device__ void phase_s2(const Params& p, int layer) {
    unsigned* ST32 = (unsigned*)(p.ws + WS_ST);
    const float* DEC = (const float*)(p.ws + WS_DEC);
    constexpr int NP = 32 * 64 * 128 / 2;
    const int gtid = blockIdx.x * NTHREADS + opaque_tid(), nth = gridDim.x * NTHREADS;
    for (int idx = gtid; idx < NP; idx += nth) {
        const int h = idx >> 12;
        float s0 = 0.f, s1 = 0.f;
        for (int c0 = 0; c0 < NPCH; c0 += 16) {
            unsigned v[16]; float d[16];
#pragma unroll
            for (int j = 0; j < 16; ++j) { v[j] = ST32[(size_t)(c0 + j) * NP + idx]; d[j] = DEC[(c0 + j) * 32 + h]; }
#pragma unroll
            for (int j = 0; j < 16; ++j) {
                ST32[(size_t)(c0 + j) * NP + idx] = cvt_pk_bf16(s0, s1);
                s0 = s0 * d[j] + bf_lo(v[j]); s1 = s1 * d[j] + bf_hi(v[j]);
            }
        }
        *(f32x2*)(p.out + O_SSM_P + (size_t)layer * 262144 + 2 * (size_t)idx) = (f32x2){s0, s1};
    }
    for (int it = gtid; it < 8 * NP; it += nth) {
        const int b = it / NP, idx = it % NP, h = idx >> 12;
        const f32x2 s = *(const f32x2*)(inp(p, 4) + ((size_t)layer * 8 + b) * 262144 + 2 * (size_t)idx);
        const unsigned v = ST32[(size_t)(NPCH + b) * NP + idx];
        const float d = DEC[(NPCH + b) * 32 + h];
        ST32[(size_t)(NPCH + b) * NP + idx] = cvt_pk_bf16(s[0], s[1]);
        *(f32x2*)(p.out + O_SSM_S + ((size_t)layer * 8 + b) * 262144 + 2 * (size_t)idx) = (f32x2){s[0] * d + bf_lo(v), s[1] * d + bf_hi(v)};
    }
}

__device__ void phase_s3(const Params& p, int layer, unsigned char* lds) {
    bf16_t* s_xsT = (bf16_t*)lds;
    bf16_t* s_B = (bf16_t*)(lds + 36864);
    bf16_t* s_C = (bf16_t*)(lds + 36864 + 17408);
    bf16_t* s_M = (bf16_t*)(lds + 71680);
    float* s_dt = (float*)(lds + 108544);
    float* s_acum = s_dt + 256;
    float* s_ssq = s_acum + 256;
    const int tid = opaque_tid(), lane = tid & 63, wave = tid >> 6, fr = lane & 15, fq = lane >> 4;
    const bf16_t* proj = (const bf16_t*)(p.ws + WS_PROJ);
    bf16_t* mix = (bf16_t*)(p.ws + WS_MIX);
    const bf16_t* ST = (const bf16_t*)(p.ws + WS_ST);
    const float* hist = inp(p, 3) + (size_t)layer * 8 * 3 * 4096;
    for (int unit = blockIdx.x; unit < NCHUNK * 8; unit += gridDim.x) {
        const int c = unit >> 3, g = unit & 7, row0 = c * 64;
        const bool last_chunk = (c >= NPCH - 1);
        if (wave < 4) {
            const int h = g * 4 + wave; float dtv, acum, total;
            dt_acum(p, layer, c, h, lane, dtv, acum, total);
            s_dt[wave * 64 + lane] = dtv; s_acum[wave * 64 + lane] = acum;
        }
        {
            const int rr = tid & 7, cg = tid >> 3, l0 = rr * 8;
            const int col = (cg < 32) ? g * 256 + cg * 8 : (cg < 48 ? 2048 + g * 128 + (cg - 32) * 8 : 3072 + g * 128 + (cg - 48) * 8);
            u32x4 rows[11];
#pragma unroll
            for (int i = 0; i < 11; ++i) rows[i] = fetch_xbc8(proj, hist, c, l0 - 3 + i, col);
            const float* cw = inp(p, 12) + (size_t)layer * 4 * 4096 + col; const float* cb = inp(p, 13) + (size_t)layer * 4096 + col;
            float w[4][8], b[8];
#pragma unroll
            for (int k = 0; k < 4; ++k) { const f32x4 a = *(const f32x4*)(cw + k * 4096), bb = *(const f32x4*)(cw + k * 4096 + 4);
#pragma unroll
                for (int j = 0; j < 4; ++j) { w[k][j] = a[j]; w[k][4 + j] = bb[j]; } }
            { const f32x4 a = *(const f32x4*)cb, bb = *(const f32x4*)(cb + 4);
#pragma unroll
              for (int j = 0; j < 4; ++j) { b[j] = a[j]; b[4 + j] = bb[j]; } }
            if (last_chunk && rr == 7) {
#pragma unroll
                for (int i = 0; i < 3; ++i) {
                    float* op = (c < NPCH) ? p.out + O_CONV_P + ((size_t)layer * 3 + i) * 4096 + col
                                           : p.out + O_CONV_S + (((size_t)layer * 8 + (c - NPCH)) * 3 + i) * 4096 + col;
                    const u32x4 rv = rows[8 + i];
                    *(f32x4*)op = (f32x4){bf_lo(rv.x), bf_hi(rv.x), bf_lo(rv.y), bf_hi(rv.y)}; *(f32x4*)(op + 4) = (f32x4){bf_lo(rv.z), bf_hi(rv.z), bf_lo(rv.w), bf_hi(rv.w)};
                }
            }
            if (cg < 32) {
#pragma unroll
                for (int j = 0; j < 8; ++j) {
                    float o[8];
#pragma unroll
                    for (int i = 0; i < 8; ++i) {
                        float v = b[j];
#pragma unroll
                        for (int k = 0; k < 4; ++k) v += w[k][j] * bfv(rows[i + k], j);
                        o[i] = silu_f(v);
                    }
                    u32x4 pk; pk.x = cvt_pk_bf16(o[0], o[1]); pk.y = cvt_pk_bf16(o[2], o[3]); pk.z = cvt_pk_bf16(o[4], o[5]); pk.w = cvt_pk_bf16(o[6], o[7]);
                    *(u32x4*)(s_xsT + (cg * 8 + j) * 72 + l0) = pk;
                }
            } else {
                bf16_t* dst = (cg < 48) ? s_B + (cg - 32) * 8 : s_C + (cg - 48) * 8;
#pragma unroll
                for (int i = 0; i < 8; ++i) {
                    float o[8];
#pragma unroll
                    for (int j = 0; j < 8; ++j) {
                        float v = b[j];
#pragma unroll
                        for (int k = 0; k < 4; ++k) v += w[k][j] * bfv(rows[i + k], j);
                        o[j] = silu_f(v);
                    }
                    u32x4 pk; pk.x = cvt_pk_bf16(o[0], o[1]); pk.y = cvt_pk_bf16(o[2], o[3]); pk.z = cvt_pk_bf16(o[4], o[5]); pk.w = cvt_pk_bf16(o[6], o[7]);
                    *(u32x4*)(dst + (l0 + i) * 136) = pk;
                }
            }
        }
        __syncthreads();
        const int hh_y = wave >> 1, half_y = wave & 1, h_y = g * 4 + hh_y;
        u32x2 zv[2][4];
#pragma unroll
        for (int lti = 0; lti < 2; ++lti)
#pragma unroll
            for (int pt = 0; pt < 4; ++pt) zv[lti][pt] = *(const u32x2*)(proj + (size_t)(row0 + (2 * half_y + lti) * 16 + fr) * PROJ_LD + 3072 + h_y * 64 + pt * 16 + fq * 4);
        bf16x8 aPall[4][4];
        {
            const bf16_t* prev = ST + ((size_t)(c * 32 + h_y) * 64) * 128;
#pragma unroll
            for (int ks = 0; ks < 4; ++ks)
#pragma unroll
                for (int pt = 0; pt < 4; ++pt) aPall[ks][pt] = *(const bf16x8*)(prev + (size_t)(pt * 16 + fr) * 128 + ks * 32 + fq * 8);
        }
        {
            const int lt = wave >> 1;
#pragma unroll
            for (int sti = 0; sti < 2; ++sti) {
                const int st = (wave & 1) * 2 + sti;
                f32x4 acc = (f32x4){0.f, 0.f, 0.f, 0.f};
                if (st <= lt) {
#pragma unroll
                    for (int ks = 0; ks < 4; ++ks) {
                        const bf16x8 a = *(const bf16x8*)(s_C + (lt * 16 + fr) * 136 + ks * 32 + fq * 8);
                        const bf16x8 b = *(const bf16x8*)(s_B + (st * 16 + fr) * 136 + ks * 32 + fq * 8);
                        acc = __builtin_amdgcn_mfma_f32_16x16x32_bf16(a, b, acc, 0, 0, 0);
                    }
                }
                const int s = st * 16 + fr;
#pragma unroll
                for (int hh = 0; hh < 4; ++hh) {
                    const float as = s_acum[hh * 64 + s], ds = s_dt[hh * 64 + s], Dh = inp(p, 16)[layer * 32 + g * 4 + hh];
#pragma unroll
                    for (int r = 0; r < 4; ++r) {
                        const int l = lt * 16 + fq * 4 + r;
                        float v = 0.f;
                        if (s <= l) v = acc[r] * __expf(s_acum[hh * 64 + l] - as) * ds;
                        if (s == l) v += Dh;
                        s_M[(hh * 64 + l) * 72 + s] = (bf16_t)(cvt_pk_bf16(v, 0.f) & 0xffffu);
                    }
                }
            }
        }
        __syncthreads();
        {
            const int hh = wave >> 1, half = wave & 1, h = g * 4 + hh;
            f32x4 acc1[2][4], acc2[2][4];
#pragma unroll
            for (int a = 0; a < 2; ++a)
#pragma unroll
                for (int b = 0; b < 4; ++b) { acc1[a][b] = (f32x4){0.f, 0.f, 0.f, 0.f}; acc2[a][b] = (f32x4){0.f, 0.f, 0.f, 0.f}; }
#pragma unroll
            for (int ks = 0; ks < 4; ++ks) {
                bf16x8 bC[2];
#pragma unroll
                for (int lti = 0; lti < 2; ++lti) bC[lti] = *(const bf16x8*)(s_C + ((2 * half + lti) * 16 + fr) * 136 + ks * 32 + fq * 8);
#pragma unroll
                for (int lti = 0; lti < 2; ++lti)
#pragma unroll
                    for (int pt = 0; pt < 4; ++pt) acc2[lti][pt] = __builtin_amdgcn_mfma_f32_16x16x32_bf16(aPall[ks][pt], bC[lti], acc2[lti][pt], 0, 0, 0);
            }
#pragma unroll
            for (int ks = 0; ks < 2; ++ks) {
                bf16x8 bM[2], aX[4];
#pragma unroll
                for (int lti = 0; lti < 2; ++lti) bM[lti] = *(const bf16x8*)(s_M + (hh * 64 + (2 * half + lti) * 16 + fr) * 72 + ks * 32 + fq * 8);
#pragma unroll
                for (int pt = 0; pt < 4; ++pt) aX[pt] = *(const bf16x8*)(s_xsT + (hh * 64 + pt * 16 + fr) * 72 + ks * 32 + fq * 8);
#pragma unroll
                for (int lti = 0; lti < 2; ++lti)
#pragma unroll
                    for (int pt = 0; pt < 4; ++pt) acc1[lti][pt] = __builtin_amdgcn_mfma_f32_16x16x32_bf16(aX[pt], bM[lti], acc1[lti][pt], 0, 0, 0);
            }
#pragma unroll
            for (int lti = 0; lti < 2; ++lti) {
                const int l = (2 * half + lti) * 16 + fr;
                const float e = __expf(s_acum[hh * 64 + l]);
                float ss = 0.f;
#pragma unroll
                for (int pt = 0; pt < 4; ++pt) {
                    const float z0 = bf_lo(zv[lti][pt].x), z1 = bf_hi(zv[lti][pt].x), z2 = bf_lo(zv[lti][pt].y), z3 = bf_hi(zv[lti][pt].y);
                    f32x4 u = acc1[lti][pt] + e * acc2[lti][pt];
                    u[0] *= silu_f(z0); u[1] *= silu_f(z1); u[2] *= silu_f(z2); u[3] *= silu_f(z3);
                    acc1[lti][pt] = u;
                    ss += u[0] * u[0] + u[1] * u[1] + u[2] * u[2] + u[3] * u[3];
                }
                ss += __shfl_xor(ss, 16); ss += __shfl_xor(ss, 32);
                if (fq == 0) s_ssq[hh * 64 + l] = ss;
            }
            __syncthreads();
            const float* nw = inp(p, 17) + (size_t)layer * 2048 + h * 64;
#pragma unroll
            for (int lti = 0; lti < 2; ++lti) {
                const int l = (2 * half + lti) * 16 + fr;
                const float scale = rsqrtf(((s_ssq[l] + s_ssq[64 + l]) + (s_ssq[128 + l] + s_ssq[192 + l])) * (1.f / 256.f) + EPS);
#pragma unroll
                for (int pt = 0; pt < 4; ++pt) {
                    const f32x4 w4 = *(const f32x4*)(nw + pt * 16 + fq * 4);
                    const f32x4 o = acc1[lti][pt] * scale * w4;
                    u32x2 w; w.x = cvt_pk_bf16(o[0], o[1]); w.y = cvt_pk_bf16(o[2], o[3]);
                    *(u32x2*)(mix + pg8::img_off(row0 + l, 1024 + h * 64 + pt * 16 + fq * 4, D_MIX / 64)) = w;
                }
            }
        }
        __syncthreads();
    }
}

#define XB_TMO      128
#define XB_XCNT(j)  (256  + 64 * (j))
#define XB_XSUB(j)  (1280 + 64 * (j))
#define XB_XGEN(j)  (2304 + 64 * (j))
#define XB_TOP      3328
#define XB_TOPGEN   3392
#define XCD_BAR_WORDS 3456
#define XB_SPIN_CAP (1u << 18)

__device__ __forceinline__ unsigned xb_ld(unsigned* p)              { return __hip_atomic_load(p, __ATOMIC_RELAXED, __HIP_MEMORY_SCOPE_AGENT); }
__device__ __forceinline__ unsigned xb_add(unsigned* p, unsigned v) { return __hip_atomic_fetch_add(p, v, __ATOMIC_RELAXED, __HIP_MEMORY_SCOPE_AGENT); }
__device__ __forceinline__ unsigned xb_xcc_id() { return (unsigned)__builtin_amdgcn_s_getreg((3 << 11) | 20) & 0xFu; }
#define XB_SPIN(cond, bar) do { unsigned _sp = 0; while (cond) { __builtin_amdgcn_s_sleep(1); \
    if ((++_sp & 255u) == 0u) { if (xb_ld(&(bar)[XB_TMO])) break; if (_sp > XB_SPIN_CAP) { atomicAdd(&(bar)[XB_TMO], 1u); break; } } } } while (0)

struct XcdBarrier {
    unsigned* bar; unsigned x;
    volatile LAS unsigned* st;
};

__device__ __forceinline__ XcdBarrier xcd_barrier_post(unsigned* bar, volatile LAS unsigned* st) {
    XcdBarrier b; b.bar = bar; b.x = xb_xcc_id(); b.st = st;
    if (threadIdx.x == 0) (void)xb_add(&bar[XB_XCNT(b.x)], 1u);
    return b;
}
__device__ __forceinline__ void xcd_barrier_complete(unsigned* bar, unsigned x, unsigned& nloc, unsigned& nx) {
    const unsigned G = gridDim.x * gridDim.y * gridDim.z;
    unsigned sum, cnt, mine, sp = 0u;
    for (;;) {
        sum = 0u; cnt = 0u; mine = 0u;
#pragma unroll
        for (unsigned j = 0; j < 16; ++j) { const unsigned c = xb_ld(&bar[XB_XCNT(j)]); sum += c; cnt += (c > 0u) ? 1u : 0u; mine = (j == x) ? c : mine; }
        if (sum == G) break;
        __builtin_amdgcn_s_sleep(1);
        if ((++sp & 255u) == 0u) { if (xb_ld(&bar[XB_TMO])) break; if (sp > XB_SPIN_CAP) { atomicAdd(&bar[XB_TMO], 1u); break; } }
    }
    nloc = mine > 0u ? mine : 1u; nx = cnt > 0u ? cnt : 1u;
}

__device__ __forceinline__ void xcd_barrier(const XcdBarrier& b) {
    asm volatile("s_waitcnt vmcnt(0)" ::: "memory");
    __syncthreads();
    if (threadIdx.x == 0) {
        unsigned* bar = b.bar;
        __builtin_amdgcn_s_waitcnt(0);
        unsigned nloc = b.st[0], nx = b.st[1];
        if (nloc == 0u) { xcd_barrier_complete(bar, b.x, nloc, nx); b.st[0] = nloc; b.st[1] = nx; }
        const unsigned old = xb_add(&bar[XB_XSUB(b.x)], 1u);
        const unsigned gen = old / nloc;
        if (old + 1u == (gen + 1u) * nloc) {
            __builtin_amdgcn_fence(__ATOMIC_RELEASE, "agent");
            asm volatile("s_waitcnt vmcnt(0)" ::: "memory");
            const unsigned og = xb_add(&bar[XB_TOP], 1u);
            const unsigned tg = og / nx;
            if (og + 1u == (tg + 1u) * nx) xb_add(&bar[XB_TOPGEN], 1u);
            else XB_SPIN(xb_ld(&bar[XB_TOPGEN]) == tg, bar);
            __builtin_amdgcn_fence(__ATOMIC_ACQUIRE, "agent");
            xb_add(&bar[XB_XGEN(b.x)], 1u);
            asm volatile("s_waitcnt vmcnt(0)" ::: "memory");
        } else {
            XB_SPIN(xb_ld(&bar[XB_XGEN(b.x)]) == gen, bar);
            __builtin_amdgcn_fence(__ATOMIC_ACQUIRE, "agent");
            asm volatile("s_waitcnt vmcnt(0)" ::: "memory");
        }
    }
    __syncthreads();
}

#ifndef PROG_LIST
#define PROG_LIST 0,1,2,3,4,5,6,7,8,9,10,11,12,13,14,15,16,17,18,19,20,21,22,23,24
#endif
__constant__ int PROG[] = {PROG_LIST};

__global__ void __launch_bounds__(NTHREADS, 2) fwd_kernel(Params p) {
    extern __shared__ __attribute__((aligned(16))) unsigned char lds_raw[];
    LAS unsigned char* lds = (LAS unsigned char*)lds_raw;
    float* X = (float*)(p.ws + WS_X); bf16_t* H = (bf16_t*)(p.ws + WS_H); bf16_t* ACT = (bf16_t*)(p.ws + WS_PROJ); bf16_t* PROJ = (bf16_t*)(p.ws + WS_PROJ);
    bf16_t* MIX = (bf16_t*)(p.ws + WS_MIX); float* DT = (float*)(p.ws + WS_DT);
    float* PART = (float*)(p.ws + WS_ST);
    const int G = gridDim.x, cblk = blockIdx.x;
    { volatile LAS unsigned* stw = (volatile LAS unsigned*)(lds + 131072); if (threadIdx.x < 4) stw[threadIdx.x] = 0u; }
    __syncthreads();
    const XcdBarrier xbar = xcd_barrier_post((unsigned*)(p.ws + WS_CTL), (volatile LAS unsigned*)(lds + 131072));
    for (int pi = p.ph_lo; pi < p.ph_hi; ++pi) {
        const int ph = PROG[pi];
        if (ph == 0) {
            phase_convert(p, lds_raw);
            phase_norm<0>(p, inp(p, 5), 0, 0.f);
        } else {
            const int layer = (ph - 1) / 12, sub = (ph - 1) % 12;
            unsigned char* wl = p.ws + (size_t)layer * SZ_LAYERW;
            if (sub == 0 || sub == 9) {
                pg8::Gemm g{H, (const bf16_t*)(wl + (sub == 0 ? OFF_WGU1 : OFF_WGU2)), M_ROWS, 11264, H_LD, 2048};
                typedef pg8::SplitOrder<M_ROWS, 11264, 1, 2048> SO; SO S; S.init(G, cblk);
                pg8::EpiSwiglu E{ACT};
                pg8::gemm_phase<pg8::EpiSwiglu, SO, H_LD>(lds, g, S, E);
                if (layer == 0 && G == 256 && cblk >= 216) convert_deferred(p, (sub == 0 ? DEF_G1A : DEF_G1B) + (cblk - 216) * 6, 6);
            } else if (sub == 1 || sub == 10) {
                pg8::Gemm g{ACT, (const bf16_t*)(wl + (sub == 1 ? OFF_WD1 : OFF_WD2)), M_ROWS, 2048, ACT_LD, D_FF};
                typedef pg8::MixedOrder<D_FF, 11> SO; SO S; S.init(G, cblk);
                pg8::EpiAtomic E{X, PART, 0.5f};
                pg8::gemm_phase<pg8::EpiAtomic, SO, ACT_LD>(lds, g, S, E);
            } else if (sub == 7) {
                pg8::Gemm g{MIX, (const bf16_t*)(wl + OFF_WOUT), M_ROWS, 2048, MIX_LD, D_MIX};
                typedef pg8::MixedOrder<D_MIX, 12> SO; SO S; S.init(G, cblk);
                pg8::EpiAtomic E{X, PART, 1.0f};
                pg8::gemm_phase<pg8::EpiAtomic, SO, MIX_LD>(lds, g, S, E);
            } else if (sub == 2 || sub == 8) {
                if (sub == 2) phase_norm<1>(p, inp(p, 9) + (size_t)layer * 2048, 11, 0.5f);
                else phase_norm<1>(p, inp(p, 19) + (size_t)layer * 2048, 12, 1.0f);
            } else if (sub == 3) {
                pg8::Gemm g{H, (const bf16_t*)(wl + OFF_WIN), M_ROWS, N_IN_PAD, H_LD, 2048};
                typedef pg8::SplitOrder<M_ROWS, N_IN_PAD, 1, 2048> SO; SO S; S.init(G, cblk);
                pg8::EpiProj E{PROJ, DT};
                pg8::gemm_phase<pg8::EpiProj, SO, H_LD>(lds, g, S, E);
                if (layer == 0 && G == 256 && cblk >= 234) convert_deferred(p, DEF_G3 + (cblk - 234) * 6, 6);
            } else if (sub == 4) {
                phase_s1(p, layer, lds_raw);
                if (layer == 0 && G == 256 && cblk >= 64) convert_deferred(p, DEF_S1 + (cblk - 64), 1);
            } else if (sub == 5) {
                phase_s2(p, layer);
            } else if (sub == 6) {
                phase_s3(p, layer, lds_raw);
                if (layer == 0 && G == 256 && cblk >= 64) convert_deferred(p, DEF_S3 + (cblk - 64), 1);
            } else {
                if (layer == 0) phase_norm<1>(p, inp(p, 5) + 2048, 11, 0.5f);
                else phase_norm<2>(p, inp(p, 23), 11, 0.5f);
            }
        }
        if (pi + 1 < p.ph_hi) {
            if (p.ph_hi > 4096) cg::this_grid().sync();
            xcd_barrier(xbar);
        }
    }
}

#ifndef PROG_LIST
#error
#endif
static const int prog_host[] = {PROG_LIST};
#define NPROG_HOST ((int)(sizeof(prog_host) / sizeof(int)))
extern "C" void kernel_launch(void* const* d_in, const int* in_sizes, int n_in, void* d_out, int out_size, void* d_ws, size_t ws_size, hipStream_t stream) {
    static int grid = 0;
    if (grid == 0) {
        int dev = 0, cus = 0, per_cu = 0;
        hipGetDevice(&dev);
        hipDeviceGetAttribute(&cus, hipDeviceAttributeMultiprocessorCount, dev);
        if (hipFuncSetAttribute((const void*)fwd_kernel, hipFuncAttributeMaxDynamicSharedMemorySize, LDS_BYTES) != hipSuccess) fprintf(stderr, "kernel_launch: hipFuncSetAttribute failed\n");
        if (hipOccupancyMaxActiveBlocksPerMultiprocessor(&per_cu, (const void*)fwd_kernel, NTHREADS, LDS_BYTES) != hipSuccess || per_cu < 1) { fprintf(stderr, "kernel_launch: occupancy query says %d\n", per_cu); per_cu = 1; }
        (void)hipGetLastError();
        if (per_cu > 1) per_cu = 1;
        grid = cus * per_cu;
        if (ws_size < WS_END) fprintf(stderr, "kernel_launch: workspace too small: %zu < %zu\n", ws_size, (size_t)WS_END);
    }
    Params p{};
    for (int i = 0; i < 24; ++i) p.in[i] = (const float*)d_in[i];
    p.out = (float*)d_out; p.ws = (unsigned char*)d_ws;
#if ONE_LAUNCH
    hipMemsetAsync((unsigned char*)d_ws + WS_CTL, 0, 16384, stream);
    p.ph_lo = 0; p.ph_hi = NPROG_HOST;
    void* args[] = {&p};
    hipError_t e = hipLaunchCooperativeKernel((const void*)fwd_kernel, dim3(grid), dim3(NTHREADS), args, LDS_BYTES, stream);
    if (e != hipSuccess) fprintf(stderr, "cooperative launch failed: %s (grid %d)\n", hipGetErrorString(e), grid);
#else
#ifndef PH_LIST
#define PH_LIST 0,1,2,3,4,5,6,7,8,9,10,11,12,13,14,15,16,17,18,19,20,21,22,23,24
#endif
    const int phl[] = {PH_LIST};
    for (int ph : phl) {
        p.ph_lo = ph; p.ph_hi = ph + 1;
        hipLaunchKernelGGL(fwd_kernel, dim3(grid), dim3(NTHREADS), LDS_BYTES, stream, p);
    }
#endif
}
```

```cpp
#include <hip/hip_runtime.h>
#include <hip/hip_cooperative_groups.h>
#include <cstdio>
namespace cg = cooperative_groups;

#ifndef ONE_LAUNCH
#define ONE_LAUNCH 1
#endif

#define LAS __attribute__((address_space(3)))
typedef unsigned short bf16_t;
typedef short bf16x8 __attribute__((ext_vector_type(8)));
typedef float f32x4 __attribute__((ext_vector_type(4)));
typedef float f32x2 __attribute__((ext_vector_type(2)));
typedef unsigned u32x4 __attribute__((ext_vector_type(4)));
typedef unsigned u32x2 __attribute__((ext_vector_type(2)));

constexpr int D_MODEL = 2048, M_ROWS = 8704, NCHUNK = 136, NPCH = 128;
constexpr int D_FF = 5632, PROJ_LD = 9216, N_IN = 9248, N_IN_PAD = 9472, D_MIX = 3072;
constexpr int H_LD = 2048, ACT_LD = D_FF, MIX_LD = D_MIX;
constexpr float EPS = 1e-6f;
constexpr int NTHREADS = 512;
constexpr int LDS_BYTES = 131072 + 16;

constexpr size_t O_SC_P = 17825792, O_CONV_P = 17829888, O_SSM_P = 17854464, O_SC_S = 18378752, O_CONV_S = 18411520, O_SSM_S = 18608128;

constexpr size_t SZ_WGU = (size_t)11264 * H_LD * 2, SZ_WD = (size_t)2048 * ACT_LD * 2, SZ_WIN = (size_t)N_IN_PAD * H_LD * 2, SZ_WOUT = (size_t)2048 * MIX_LD * 2;
constexpr size_t OFF_WGU1 = 0, OFF_WD1 = SZ_WGU, OFF_WIN = SZ_WGU + SZ_WD, OFF_WOUT = OFF_WIN + SZ_WIN, OFF_WGU2 = OFF_WOUT + SZ_WOUT, OFF_WD2 = OFF_WGU2 + SZ_WGU;
constexpr size_t SZ_LAYERW = 2 * SZ_WGU + 2 * SZ_WD + SZ_WIN + SZ_WOUT;
constexpr size_t WS_X = 2 * SZ_LAYERW;
constexpr size_t WS_H = WS_X + (size_t)M_ROWS * 2048 * 4;
constexpr size_t WS_PROJ = WS_H + (size_t)M_ROWS * H_LD * 2;
constexpr size_t WS_MIX = WS_PROJ + (size_t)M_ROWS * PROJ_LD * 2;
constexpr size_t WS_ST = WS_MIX + (size_t)M_ROWS * MIX_LD * 2;
constexpr size_t WS_DT = WS_ST + (size_t)NCHUNK * 32 * 64 * 128 * 2;
constexpr size_t WS_DEC = WS_DT + (size_t)M_ROWS * 32 * 4;
constexpr size_t WS_CTL = WS_DEC + (size_t)NCHUNK * 32 * 4;
constexpr size_t WS_END = WS_CTL + 16384;

struct Params { const float* in[24]; float* out; unsigned char* ws; int ph_lo, ph_hi; };

__device__ __forceinline__ const float* inp(const Params& p, int i) { asm volatile("" : "+s"(i)); return p.in[i]; }
__device__ __forceinline__ float bf_lo(unsigned u) { return __uint_as_float(u << 16); }
__device__ __forceinline__ float bf_hi(unsigned u) { return __uint_as_float(u & 0xffff0000u); }
typedef __bf16 bf16x2v __attribute__((ext_vector_type(2)));
__device__ __forceinline__ unsigned cvt_pk_bf16(float lo, float hi) { f32x2 v = {lo, hi}; bf16x2v b = __builtin_convertvector(v, bf16x2v); return __builtin_bit_cast(unsigned, b); }
__device__ __forceinline__ float silu_f(float x) { return x * __builtin_amdgcn_rcpf(1.f + __expf(-x)); }
__device__ __forceinline__ float softplus_f(float x) { return x > 20.f ? x : log1pf(expf(x)); }
__device__ __forceinline__ int opaque_tid() { int t = threadIdx.x; asm volatile("" : "+v"(t)); return t; }
__device__ __forceinline__ float bfv(const u32x4& v, int j) { const unsigned w = v[j >> 1]; return (j & 1) ? bf_hi(w) : bf_lo(w); }

namespace pg8 {
constexpr int BM = 256, BK = 64, HALF = 128, HTB = HALF * BK * 2, STAGE_BYTES = 8 * HTB, NXCD = 8, WGM = 8;
__host__ __device__ __forceinline__ int lds_byte(int r, int c) { const int st = (r >> 4) * 2 + (c >> 5), rr = r & 15, cc = c & 31, ob = rr * 64 + cc * 2; return st * 1024 + (ob ^ (((ob >> 9) & 1) << 5)); }
__host__ __device__ __forceinline__ void stage_rc(int b, int& R, int& C) { const int st = b / 1024, sb = b % 1024, swz = sb ^ (((sb >> 9) & 1) << 5); R = (st >> 1) * 16 + swz / 64; C = (st & 1) * 32 + (swz % 64) / 2; }
__host__ __device__ __forceinline__ int perm32(int rho) { const int n = rho >> 4, i = rho & 15; return 8 * (i >> 2) + 4 * n + (i & 3); }

__host__ __device__ __forceinline__ int perm32_inv(int s) { return 16 * ((s >> 2) & 1) + 4 * (s >> 3) + (s & 3); }
__device__ __forceinline__ size_t img_off(int row, int col, int KT) {
    return ((size_t)((row >> 8) * KT + (col >> 6)) << 14) + (size_t)(((row >> 7) & 1) << 13) + (size_t)(lds_byte(row & 127, col & 63) >> 1);
}
struct Unit { int pm, pn, kofs, nt, part; };
struct Gemm { const bf16_t* A; const bf16_t* Bt; int M, N, ld, Kc; };

template <int M, int N, int KS, int Kc>
struct SplitOrder {
    static constexpr int nM = M / BM, nN = N / BM, nwg = nM * nN;
    int G, c;
    __device__ void init(int G_, int c_) { G = G_; c = c_; }
    __device__ bool next(int i, Unit& u) const {
        const int L = i * G + c; if (L >= nwg * KS) return false;
        const int ks = L / nwg; int wgid = L - ks * nwg;
        { const int q = nwg / NXCD, r = nwg % NXCD, xcd = wgid % NXCD, off = wgid / NXCD; wgid = (xcd < r ? xcd * (q + 1) : r * (q + 1) + (xcd - r) * q) + off; }
        const int nig = WGM * nN, gid = wgid / nig, fm = gid * WGM, gsz = (nM - fm) < WGM ? (nM - fm) : WGM;
        u.pm = fm + ((wgid % nig) % gsz); u.pn = (wgid % nig) / gsz; u.kofs = ks * Kc; u.nt = Kc / BK; u.part = -1; return true;
    }
};


template <int K, int KS>
struct MixedOrder {
    static constexpr int nFull = 256, KcP = K / KS;
    int G, c;
    __device__ void init(int G_, int c_) { G = G_; c = c_; }
    __device__ bool next(int i, Unit& u) const {
        const int L = i * G + c;
        if (L < nFull) {
            int wgid = L; { const int q = nFull / NXCD, xcd = wgid % NXCD, off = wgid / NXCD; wgid = xcd * q + off; }
            const int nig = WGM * 8, gid = wgid / nig, fm = gid * WGM;
            u.pm = fm + ((wgid % nig) % WGM); u.pn = (wgid % nig) / WGM; u.kofs = 0; u.nt = K / BK; u.part = -1; return true;
        }
        const int q = L - nFull; if (q >= 16 * KS) return false;
        const int tile = q / KS, ks = q - tile * KS;
        u.pm = 32 + (tile >> 3); u.pn = tile & 7; u.kofs = ks * KcP; u.nt = KcP / BK; u.part = ks; return true;
    }
};

struct EpiSwiglu {
    static constexpr bool PERM = true;
    bf16_t* O;
    __device__ __forceinline__ void operator()(const f32x4 (&acc)[2][2][4][2], const Unit& u, int wr, int wc, int fr, int fq) const {
        const int row0 = u.pm * BM + wr * 64 + fr, col0 = u.pn * 128 + wc * 32 + 8 * fq;
#pragma unroll
        for (int ai = 0; ai < 2; ++ai)
#pragma unroll
            for (int m = 0; m < 4; ++m) {
                bf16_t* rowp = O + img_off(row0 + ai * HALF + m * 16, col0, D_FF / 64);
                const f32x4 g0 = acc[ai][0][m][0], g1 = acc[ai][0][m][1], u0 = acc[ai][1][m][0], u1 = acc[ai][1][m][1];
                u32x4 w;
                w.x = cvt_pk_bf16(silu_f(g0[0]) * u0[0], silu_f(g0[1]) * u0[1]); w.y = cvt_pk_bf16(silu_f(g0[2]) * u0[2], silu_f(g0[3]) * u0[3]);
                w.z = cvt_pk_bf16(silu_f(g1[0]) * u1[0], silu_f(g1[1]) * u1[1]); w.w = cvt_pk_bf16(silu_f(g1[2]) * u1[2], silu_f(g1[3]) * u1[3]);
                *(u32x4*)rowp = w;
            }
    }
};
struct EpiAtomic {
    static constexpr bool PERM = false;
    float* X; float* PART; float scale;
    __device__ __forceinline__ void operator()(const f32x4 (&acc)[2][2][4][2], const Unit& u, int wr, int wc, int fr, int fq) const {
        const int row0 = u.pm * BM + wr * 64 + fr, col0 = u.pn * BM + wc * 32 + 4 * fq;
        if (u.part < 0) {
#pragma unroll
            for (int ai = 0; ai < 2; ++ai)
#pragma unroll
                for (int m = 0; m < 4; ++m) {
                    float* rowp = X + (size_t)(row0 + ai * HALF + m * 16) * D_MODEL + col0;
                    f32x4 xv[2][2];
#pragma unroll
                    for (int bj = 0; bj < 2; ++bj)
#pragma unroll
                        for (int n = 0; n < 2; ++n) xv[bj][n] = *(const f32x4*)(rowp + bj * HALF + n * 16);
#pragma unroll
                    for (int bj = 0; bj < 2; ++bj)
#pragma unroll
                        for (int n = 0; n < 2; ++n) *(f32x4*)(rowp + bj * HALF + n * 16) = xv[bj][n] + scale * acc[ai][bj][m][n];
                }
        } else {
            float* base = PART + (size_t)u.part * (512 * 2048);
#pragma unroll
            for (int ai = 0; ai < 2; ++ai)
#pragma unroll
                for (int m = 0; m < 4; ++m) {
                    float* rowp = base + (size_t)(row0 - 8192 + ai * HALF + m * 16) * D_MODEL + col0;
#pragma unroll
                    for (int bj = 0; bj < 2; ++bj)
#pragma unroll
                        for (int n = 0; n < 2; ++n) *(f32x4*)(rowp + bj * HALF + n * 16) = acc[ai][bj][m][n];
                }
        }
    }
};
struct EpiProj {
    static constexpr bool PERM = true;
    bf16_t* P; float* DT;
    __device__ __forceinline__ void operator()(const f32x4 (&acc)[2][2][4][2], const Unit& u, int wr, int wc, int fr, int fq) const {
        const int row0 = u.pm * BM + wr * 64 + fr;
        if (u.pn < 36) {
            const int col0 = u.pn * BM + wc * 32 + 8 * fq;
#pragma unroll
            for (int ai = 0; ai < 2; ++ai)
#pragma unroll
                for (int m = 0; m < 4; ++m) {
                    bf16_t* rowp = P + (size_t)(row0 + ai * HALF + m * 16) * PROJ_LD + col0;
#pragma unroll
                    for (int bj = 0; bj < 2; ++bj) {
                        const f32x4 v0 = acc[ai][bj][m][0], v1 = acc[ai][bj][m][1];
                        u32x4 w; w.x = cvt_pk_bf16(v0[0], v0[1]); w.y = cvt_pk_bf16(v0[2], v0[3]); w.z = cvt_pk_bf16(v1[0], v1[1]); w.w = cvt_pk_bf16(v1[2], v1[3]);
                        *(u32x4*)(rowp + bj * HALF) = w;
                    }
                }
        } else if (wc == 0) {
#pragma unroll
            for (int ai = 0; ai < 2; ++ai)
#pragma unroll
                for (int m = 0; m < 4; ++m) {
                    float* rowp = DT + (size_t)(row0 + ai * HALF + m * 16) * 32 + 8 * fq;
                    *(f32x4*)rowp = acc[ai][0][m][0]; *(f32x4*)(rowp + 4) = acc[ai][0][m][1];
                }
        }
    }
};

template <class Epi, class Sched, int LD>
__device__ __forceinline__ void gemm_phase(LAS unsigned char* lds, const Gemm g, const Sched& S, const Epi& E) {
    const int tid = opaque_tid(), wid = __builtin_amdgcn_readfirstlane(tid >> 6), lane = tid & 63, wr = wid >> 2, wc = wid & 3, fr = lane & 15, fq = lane >> 4;
    constexpr int K = LD;
    unsigned voffA[2], voffB[2];
#pragma unroll
    for (int i = 0; i < 2; ++i) { voffA[i] = (unsigned)(tid * 16 + i * 8192); voffB[i] = voffA[i]; }
    const size_t kstep = (size_t)(2 * HTB);
    const size_t hstep = (size_t)HTB;
    const size_t tstep = (size_t)(K / BK) * kstep;
    const unsigned ldsw = (unsigned)wid * 1024u;
    const int aoff = lds_byte(wr * 64 + fr, fq * 8), boff = lds_byte(wc * 32 + fr, fq * 8);
#define PG8_SA(b, h) (((b) * 2 + (h)) * HTB)
#define PG8_SB(b, h) ((4 + (b) * 2 + (h)) * HTB)
#define PG8_STAGE(bufoff, gbase, voff) do { _Pragma("unroll") for (int _i = 0; _i < 2; ++_i) \
        __builtin_amdgcn_global_load_lds((const unsigned*)((const char*)(gbase) + (voff)[_i]), (LAS unsigned*)(lds + (bufoff) + ldsw + _i * 8192), 16, 0, 0); } while (0)
#define PG8_LDA(dst, b, h) do { _Pragma("unroll") for (int m = 0; m < 4; ++m) _Pragma("unroll") for (int k = 0; k < 2; ++k) dst[m][k] = *(const LAS bf16x8*)(lds + PG8_SA(b, h) + aoff + m * 2048 + k * 1024); } while (0)
#define PG8_LDB(dst, b, h) do { _Pragma("unroll") for (int n = 0; n < 2; ++n) _Pragma("unroll") for (int k = 0; k < 2; ++k) dst[n][k] = *(const LAS bf16x8*)(lds + PG8_SB(b, h) + boff + n * 2048 + k * 1024); } while (0)
#define PG8_MMA(ai, bj, At, Bt) do { __builtin_amdgcn_s_setprio(1); _Pragma("unroll") for (int m = 0; m < 4; ++m) _Pragma("unroll") for (int n = 0; n < 2; ++n) _Pragma("unroll") for (int k = 0; k < 2; ++k) \
        acc[ai][bj][m][n] = __builtin_amdgcn_mfma_f32_16x16x32_bf16(Bt[n][k], At[m][k], acc[ai][bj][m][n], 0, 0, 0); __builtin_amdgcn_s_setprio(0); } while (0)
#define PG8_WAIT_V(n) asm volatile("s_waitcnt vmcnt(" #n ")" ::: "memory")
#define PG8_WAIT_L(n) asm volatile("s_waitcnt lgkmcnt(" #n ")" ::: "memory")
#define PG8_BAR __builtin_amdgcn_s_barrier()
#define PG8_SCHED __builtin_amdgcn_sched_barrier(0)
    Unit cur, nxt; int ui = 0;
    if (!S.next(0, cur)) return;
    f32x4 acc[2][2][4][2];
#pragma unroll
    for (int a = 0; a < 2; ++a)
#pragma unroll
        for (int b = 0; b < 2; ++b)
#pragma unroll
            for (int m = 0; m < 4; ++m)
#pragma unroll
                for (int n = 0; n < 2; ++n) acc[a][b][m][n] = (f32x4){0.f, 0.f, 0.f, 0.f};
    bf16x8 At[4][2], B0[2][2], B1[2][2];
    const char* cA = (const char*)g.A + (size_t)cur.pm * tstep + (size_t)(cur.kofs / BK) * kstep; const char* cB = (const char*)g.Bt + (size_t)cur.pn * tstep + (size_t)(cur.kofs / BK) * kstep;
    PG8_STAGE(PG8_SB(0, 0), cB, voffB); PG8_STAGE(PG8_SA(0, 0), cA, voffA); PG8_STAGE(PG8_SB(0, 1), cB + hstep, voffB); PG8_STAGE(PG8_SA(0, 1), cA + hstep, voffA);
    if (wr == 1) PG8_BAR;
    PG8_WAIT_V(4); PG8_BAR;
    PG8_STAGE(PG8_SB(1, 0), cB + kstep, voffB); PG8_STAGE(PG8_SA(1, 0), cA + kstep, voffA); PG8_STAGE(PG8_SB(1, 1), cB + hstep + kstep, voffB);
    PG8_WAIT_V(6); PG8_BAR;
    for (;;) {
        const bool has_next = S.next(ui + 1, nxt);
        const char* nA = has_next ? (const char*)g.A + (size_t)nxt.pm * tstep + (size_t)(nxt.kofs / BK) * kstep : cA; const char* nB = has_next ? (const char*)g.Bt + (size_t)nxt.pn * tstep + (size_t)(nxt.kofs / BK) * kstep : cB;
        const int nt = cur.nt;
        for (int t = 0; t < nt; t += 2) {
            const bool last = (t == nt - 2);
            const char* a1 = cA + (size_t)(t + 1) * kstep;
            const char* a2 = last ? nA : cA + (size_t)(t + 2) * kstep; const char* b2 = last ? nB : cB + (size_t)(t + 2) * kstep;
            const char* a3 = a2 + kstep; const char* b3 = b2 + kstep;
            PG8_LDB(B0, 0, 0); PG8_SCHED; PG8_LDA(At, 0, 0); PG8_STAGE(PG8_SA(1, 1), a1 + hstep, voffA);
            PG8_WAIT_L(8); PG8_BAR; PG8_WAIT_L(0); PG8_MMA(0, 0, At, B0); PG8_BAR; PG8_SCHED;
            PG8_LDB(B1, 0, 1); PG8_STAGE(PG8_SB(0, 0), b2, voffB);
            PG8_BAR; PG8_WAIT_L(0); PG8_MMA(0, 1, At, B1); PG8_BAR;
            PG8_LDA(At, 0, 1); PG8_STAGE(PG8_SA(0, 0), a2, voffA);
            PG8_BAR; PG8_WAIT_L(0); PG8_MMA(1, 0, At, B0); PG8_BAR; PG8_SCHED;
            PG8_STAGE(PG8_SB(0, 1), b2 + hstep, voffB);
            PG8_WAIT_V(6); PG8_BAR; PG8_MMA(1, 1, At, B1); PG8_BAR;
            PG8_LDB(B0, 1, 0); PG8_SCHED; PG8_LDA(At, 1, 0); PG8_STAGE(PG8_SA(0, 1), a2 + hstep, voffA);
            PG8_WAIT_L(8); PG8_BAR; PG8_WAIT_L(0); PG8_MMA(0, 0, At, B0); PG8_BAR; PG8_SCHED;
            PG8_LDB(B1, 1, 1); PG8_STAGE(PG8_SB(1, 0), b3, voffB);
            PG8_BAR; PG8_WAIT_L(0); PG8_MMA(0, 1, At, B1); PG8_BAR;
            PG8_LDA(At, 1, 1); PG8_STAGE(PG8_SA(1, 0), a3, voffA);
            PG8_BAR; PG8_WAIT_L(0); PG8_MMA(1, 0, At, B0); PG8_BAR; PG8_SCHED;
            PG8_STAGE(PG8_SB(1, 1), b3 + hstep, voffB);
            PG8_WAIT_V(6); PG8_BAR; PG8_MMA(1, 1, At, B1); PG8_BAR;
        }
        E(acc, cur, wr, wc, fr, fq);
        if (!has_next) break;
#pragma unroll
        for (int a = 0; a < 2; ++a)
#pragma unroll
            for (int b = 0; b < 2; ++b)
#pragma unroll
                for (int m = 0; m < 4; ++m)
#pragma unroll
                    for (int n = 0; n < 2; ++n) acc[a][b][m][n] = (f32x4){0.f, 0.f, 0.f, 0.f};
        cur = nxt; cA = nA; cB = nB; ++ui;
    }
    PG8_WAIT_V(0);
    if (wr == 0) PG8_BAR;
    PG8_BAR;
#undef PG8_SA
#undef PG8_SB
#undef PG8_STAGE
#undef PG8_LDA
#undef PG8_LDB
#undef PG8_MMA
#undef PG8_WAIT_V
#undef PG8_WAIT_L
#undef PG8_BAR
#undef PG8_SCHED
}
}

struct TileInfo { const float* src; bf16_t* dst; int K, N, k0, n0, mode, perm; };
constexpr int CONV_TILES_LAYER = 6 * 352 + 580 + 192;

__device__ __forceinline__ void conv_decode(const Params& p, int t, TileInfo& ti) {
    const int layer = t / CONV_TILES_LAYER; int r = t % CONV_TILES_LAYER;
    unsigned char* wl = p.ws + (size_t)layer * SZ_LAYERW;
    int ntn;
    if (r < 352)       { ti.src = inp(p, 6)  + (size_t)layer * 2048 * 5632; ti.dst = (bf16_t*)(wl + OFF_WGU1); ti.K = 2048; ti.N = 5632; ti.mode = 1; ti.perm = 1; ntn = 88; }
    else if (r < 704)  { r -= 352;  ti.src = inp(p, 7)  + (size_t)layer * 2048 * 5632; ti.dst = (bf16_t*)(wl + OFF_WGU1); ti.K = 2048; ti.N = 5632; ti.mode = 2; ti.perm = 1; ntn = 88; }
    else if (r < 1056) { r -= 704;  ti.src = inp(p, 8)  + (size_t)layer * 5632 * 2048; ti.dst = (bf16_t*)(wl + OFF_WD1);  ti.K = 5632; ti.N = 2048; ti.mode = 0; ti.perm = 0; ntn = 32; }
    else if (r < 1636) { r -= 1056; ti.src = inp(p, 10) + (size_t)layer * 2048 * N_IN; ti.dst = (bf16_t*)(wl + OFF_WIN);  ti.K = 2048; ti.N = N_IN; ti.mode = 0; ti.perm = 1; ntn = 145; }
    else if (r < 1828) { r -= 1636; ti.src = inp(p, 18) + (size_t)layer * 3072 * 2048; ti.dst = (bf16_t*)(wl + OFF_WOUT); ti.K = 3072; ti.N = 2048; ti.mode = 0; ti.perm = 0; ntn = 32; }
    else if (r < 2180) { r -= 1828; ti.src = inp(p, 20) + (size_t)layer * 2048 * 5632; ti.dst = (bf16_t*)(wl + OFF_WGU2); ti.K = 2048; ti.N = 5632; ti.mode = 1; ti.perm = 1; ntn = 88; }
    else if (r < 2532) { r -= 2180; ti.src = inp(p, 21) + (size_t)layer * 2048 * 5632; ti.dst = (bf16_t*)(wl + OFF_WGU2); ti.K = 2048; ti.N = 5632; ti.mode = 2; ti.perm = 1; ntn = 88; }
    else               { r -= 2532; ti.src = inp(p, 22) + (size_t)layer * 5632 * 2048; ti.dst = (bf16_t*)(wl + OFF_WD2);  ti.K = 5632; ti.N = 2048; ti.mode = 0; ti.perm = 0; ntn = 32; }
    ti.k0 = (r / ntn) * 512; ti.n0 = (r % ntn) * 64;
}
__device__ __forceinline__ void conv_load(const TileInfo& ti, f32x4 (&r)[16], int tid) {
    const int lane = tid & 63, wave = tid >> 6, n = ti.n0 + (lane & 15) * 4, k = ti.k0 + wave * 64 + (lane >> 4) * 16;
#pragma unroll
    for (int i = 0; i < 16; ++i) {
        if (n < ti.N) r[i] = __builtin_nontemporal_load((const f32x4*)(ti.src + (size_t)(k + i) * ti.N + n));
        else r[i] = (f32x4){0.f, 0.f, 0.f, 0.f};
    }
}
constexpr int DEF_TILES = 996, DEF_G1A = 0, DEF_G1B = 240, DEF_G3 = 480, DEF_S1 = 612, DEF_S3 = 804;
constexpr int DEF2_FIRST = 1828, DEF2_TILES = 756, DEF2_G1A = 1828, DEF2_G3 = 2068, DEF2_S1 = 2200, DEF2_S3 = 2392;
__device__ __forceinline__ int conv_tile_id(int t, bool deferred) {
    if (!deferred || t < CONV_TILES_LAYER) return t;
    const int u = t - CONV_TILES_LAYER + DEF_TILES;
    return CONV_TILES_LAYER + (u < DEF2_FIRST ? u : u + DEF2_TILES);
}

__device__ __forceinline__ void convert_tiles(const Params& p, int tid, int first, int stride, int count, bool phase0, bool deferred) {
    f32x4 r[16], rn[16];
    if (count > 0) { TileInfo t0; conv_decode(p, phase0 ? conv_tile_id(first, deferred) : first, t0); conv_load(t0, r, tid); }
    for (int i = 0; i < count; ++i) {
        const int t = first + i * stride;
        if (i + 1 < count) { TileInfo tin; conv_decode(p, phase0 ? conv_tile_id(t + stride, deferred) : t + stride, tin); conv_load(tin, rn, tid); }
        {
            TileInfo ti; conv_decode(p, phase0 ? conv_tile_id(t, deferred) : t, ti);
            const int lane = tid & 63, wave = tid >> 6, n = ti.n0 + (lane & 15) * 4, k = ti.k0 + wave * 64 + (lane >> 4) * 16;
            if (n < ti.N) {
#pragma unroll
                for (int j = 0; j < 4; ++j) {
                    u32x4 w0, w1;
                    w0.x = cvt_pk_bf16(r[0][j], r[1][j]);  w0.y = cvt_pk_bf16(r[2][j], r[3][j]);   w0.z = cvt_pk_bf16(r[4][j], r[5][j]);   w0.w = cvt_pk_bf16(r[6][j], r[7][j]);
                    w1.x = cvt_pk_bf16(r[8][j], r[9][j]);  w1.y = cvt_pk_bf16(r[10][j], r[11][j]); w1.z = cvt_pk_bf16(r[12][j], r[13][j]); w1.w = cvt_pk_bf16(r[14][j], r[15][j]);
                    const int nn = n + j;
                    int row = nn;
                    if (ti.mode == 1) row = (nn >> 7) * 256 + (nn & 127);
                    else if (ti.mode == 2) row = (nn >> 7) * 256 + 128 + (nn & 127);
                    if (ti.perm) row = (row & ~31) + pg8::perm32_inv(row & 31);
                    *(u32x4*)(ti.dst + pg8::img_off(row, k, ti.K >> 6)) = w0; *(u32x4*)(ti.dst + pg8::img_off(row, k + 8, ti.K >> 6)) = w1;
                }
            }
        }
#pragma unroll
        for (int i2 = 0; i2 < 16; ++i2) r[i2] = rn[i2];
    }
}
__device__ __forceinline__ void convert_deferred(const Params& p, int l1_first, int count) {
    int f = CONV_TILES_LAYER + l1_first; asm volatile("" : "+s"(f));
    convert_tiles(p, opaque_tid(), f, 1, count, false, true);
}
__device__ void phase_convert(const Params& p, unsigned char* lds_raw) {
    const int tid = opaque_tid();
    const bool deferred = (gridDim.x == 256);
    const int total = deferred ? 2 * CONV_TILES_LAYER - DEF_TILES - DEF2_TILES : 2 * CONV_TILES_LAYER;
    int t = blockIdx.x; asm volatile("" : "+s"(t));
    const int count = (t < total) ? (total - t + (int)gridDim.x - 1) / (int)gridDim.x : 0;
    convert_tiles(p, tid, t, gridDim.x, count, true, deferred);
    for (int layer = 0; layer < 2; ++layer) {
        bf16_t* wz = (bf16_t*)(p.ws + (size_t)layer * SZ_LAYERW + OFF_WIN);
        for (int i = blockIdx.x * NTHREADS + tid; i < (N_IN_PAD - N_IN) * 256; i += gridDim.x * NTHREADS)
            *(u32x4*)(wz + pg8::img_off(N_IN + (i >> 8), (i & 255) * 8, 32)) = (u32x4){0u, 0u, 0u, 0u};
    }
}

template <int MODE>
__device__ __forceinline__ void norm_row(const Params& p, const f32x4 (&g)[8], int r, int lane, int nparts, float pscale) {
    float* X = (float*)(p.ws + WS_X); bf16_t* H = (bf16_t*)(p.ws + WS_H);
    const float* src = (MODE == 0) ? (r < 8192 ? inp(p, 0) + (size_t)r * 2048 : inp(p, 1) + (size_t)(r - 8192) * 2048) : X + (size_t)r * 2048;
    f32x4 v[8]; float ss = 0.f;
#pragma unroll
    for (int i = 0; i < 8; ++i) v[i] = *(const f32x4*)(src + i * 256 + lane * 4);
    if (MODE != 0 && nparts > 0 && r >= 8192) {
        const float* pp = (const float*)(p.ws + WS_ST) + (size_t)(r - 8192) * 2048 + lane * 4;
        f32x4 a[8];
#pragma unroll
        for (int i = 0; i < 8; ++i) a[i] = (f32x4){0.f, 0.f, 0.f, 0.f};
        for (int k = 0; k < nparts; ++k) {
#pragma unroll
            for (int i = 0; i < 8; ++i) a[i] += *(const f32x4*)(pp + (size_t)k * (512 * 2048) + i * 256);
        }
#pragma unroll
        for (int i = 0; i < 8; ++i) { v[i] += pscale * a[i]; *(f32x4*)(X + (size_t)r * 2048 + i * 256 + lane * 4) = v[i]; }
    }
#pragma unroll
    for (int i = 0; i < 8; ++i) ss += v[i][0] * v[i][0] + v[i][1] * v[i][1] + v[i][2] * v[i][2] + v[i][3] * v[i][3];
#pragma unroll
    for (int o = 32; o >= 1; o >>= 1) ss += __shfl_xor(ss, o);
    const float rstd = rsqrtf(ss * (1.f / 2048.f) + EPS);
#pragma unroll
    for (int i = 0; i < 8; ++i) {
        if (MODE == 0) *(f32x4*)(X + (size_t)r * 2048 + i * 256 + lane * 4) = v[i];
        const f32x4 o = v[i] * rstd * g[i];
        if (MODE < 2) { u32x2 w; w.x = cvt_pk_bf16(o[0], o[1]); w.y = cvt_pk_bf16(o[2], o[3]); *(u32x2*)(H + pg8::img_off(r, i * 256 + lane * 4, 32)) = w; }
        else *(f32x4*)(p.out + (size_t)r * 2048 + i * 256 + lane * 4) = o;
    }
}
template <int MODE>
__device__ void phase_norm(const Params& p, const float* gamma, int nparts, float pscale) {
    const int tid = opaque_tid(), lane = tid & 63, wave = tid >> 6;
    f32x4 g[8];
#pragma unroll
    for (int i = 0; i < 8; ++i) g[i] = *(const f32x4*)(gamma + i * 256 + lane * 4);
    if (wave < 2) for (int s = blockIdx.x * 2 + wave; s < 512; s += gridDim.x * 2) norm_row<MODE>(p, g, 8192 + s, lane, nparts, pscale);
    for (int r = blockIdx.x * 8 + wave; r < 8192; r += gridDim.x * 8) norm_row<MODE>(p, g, r, lane, nparts, pscale);
}

__device__ __forceinline__ u32x4 fetch_xbc8(const bf16_t* proj, const float* hist, int c, int lrow, int col) {
    if (lrow >= 0 || (c > 0 && c < NPCH)) return *(const u32x4*)(proj + (size_t)(c * 64 + lrow) * PROJ_LD + 5120 + col);
    if (c == 0) return (u32x4){0u, 0u, 0u, 0u};
    const float* h = hist + ((size_t)(c - NPCH) * 3 + (3 + lrow)) * 4096 + col;
    const f32x4 a = *(const f32x4*)h, b = *(const f32x4*)(h + 4);
    u32x4 w; w.x = cvt_pk_bf16(a[0], a[1]); w.y = cvt_pk_bf16(a[2], a[3]); w.z = cvt_pk_bf16(b[0], b[1]); w.w = cvt_pk_bf16(b[2], b[3]);
    return w;
}
__device__ __forceinline__ void dt_acum(const Params& p, int layer, int c, int h, int lane, float& dtv, float& acum, float& total) {
    const float* DT = (const float*)(p.ws + WS_DT);
    const float raw = DT[(size_t)(c * 64 + lane) * 32 + h];
    dtv = softplus_f(raw + inp(p, 14)[layer * 32 + h]);
    const float A = -expf(inp(p, 15)[layer * 32 + h]);
    float a = dtv * A;
#pragma unroll
    for (int o = 1; o < 64; o <<= 1) { const float t = __shfl_up(a, o); if (lane >= o) a += t; }
    acum = a; total = __shfl(a, 63);
}

__device__ void phase_s1(const Params& p, int layer, unsigned char* lds) {
    bf16_t* s_xwT = (bf16_t*)lds;
    bf16_t* s_BT = (bf16_t*)(lds + 36864);
    float* s_w = (float*)(lds + 55296);
    const int tid = opaque_tid(), lane = tid & 63, wave = tid >> 6, fr = lane & 15, fq = lane >> 4;
    const bf16_t* proj = (const bf16_t*)(p.ws + WS_PROJ);
    bf16_t* mix = (bf16_t*)(p.ws + WS_MIX);
    bf16_t* ST = (bf16_t*)(p.ws + WS_ST);
    float* DEC = (float*)(p.ws + WS_DEC);
    const float* hist = inp(p, 3) + (size_t)layer * 8 * 3 * 4096;
    for (int unit = blockIdx.x; unit < NCHUNK * 8; unit += gridDim.x) {
        const int c = unit >> 3, g = unit & 7, row0 = c * 64;
        const bool last_chunk = (c >= NPCH - 1);
        if (wave < 4) {
            const int h = g * 4 + wave; float dtv, acum, total;
            dt_acum(p, layer, c, h, lane, dtv, acum, total);
            s_w[wave * 64 + lane] = dtv * __expf(total - acum);
            if (lane == 0) DEC[c * 32 + h] = __expf(total);
        }
        __syncthreads();
        if (tid < 384) {
            const int rr = tid & 7, cg = tid >> 3, l0 = rr * 8;
            const int col = (cg < 32) ? g * 256 + cg * 8 : 2048 + g * 128 + (cg - 32) * 8;
            u32x4 rows[11];
#pragma unroll
            for (int i = 0; i < 11; ++i) rows[i] = fetch_xbc8(proj, hist, c, l0 - 3 + i, col);
            const float* cw = inp(p, 12) + (size_t)layer * 4 * 4096 + col; const float* cb = inp(p, 13) + (size_t)layer * 4096 + col;
            float w[4][8], b[8];
#pragma unroll
            for (int k = 0; k < 4; ++k) { const f32x4 a = *(const f32x4*)(cw + k * 4096), bb = *(const f32x4*)(cw + k * 4096 + 4);
#pragma unroll
                for (int j = 0; j < 4; ++j) { w[k][j] = a[j]; w[k][4 + j] = bb[j]; } }
            { const f32x4 a = *(const f32x4*)cb, bb = *(const f32x4*)(cb + 4);
#pragma unroll
              for (int j = 0; j < 4; ++j) { b[j] = a[j]; b[4 + j] = bb[j]; } }
            float sc[8];
#pragma unroll
            for (int i = 0; i < 8; ++i) sc[i] = (cg < 32) ? s_w[(cg >> 3) * 64 + l0 + i] : 1.f;
            bf16_t* dstT = (cg < 32) ? s_xwT + (cg * 8) * 72 + l0 : s_BT + ((cg - 32) * 8) * 72 + l0;
#pragma unroll
            for (int j = 0; j < 8; ++j) {
                float o[8];
#pragma unroll
                for (int i = 0; i < 8; ++i) {
                    float v = b[j];
#pragma unroll
                    for (int k = 0; k < 4; ++k) v += w[k][j] * bfv(rows[i + k], j);
                    o[i] = silu_f(v) * sc[i];
                }
                u32x4 pk; pk.x = cvt_pk_bf16(o[0], o[1]); pk.y = cvt_pk_bf16(o[2], o[3]); pk.z = cvt_pk_bf16(o[4], o[5]); pk.w = cvt_pk_bf16(o[6], o[7]);
                *(u32x4*)(dstT + j * 72) = pk;
            }
        } else {
            const int t2 = tid - 384, rr = t2 & 7, cgi = t2 >> 3, l0 = rr * 8, ch0 = g * 128 + cgi * 8;
            const float* scw = inp(p, 11) + (size_t)layer * 3 * 1024 + ch0;
            float w[3][8];
#pragma unroll
            for (int k = 0; k < 3; ++k) { const f32x4 a = *(const f32x4*)(scw + k * 1024), bb = *(const f32x4*)(scw + k * 1024 + 4);
#pragma unroll
                for (int j = 0; j < 4; ++j) { w[k][j] = a[j]; w[k][4 + j] = bb[j]; } }
            float um2[8], um1[8], u0[8];
#pragma unroll
            for (int i = 0; i < 10; ++i) {
                const int lrow = l0 - 2 + i;
#pragma unroll
                for (int j = 0; j < 8; ++j) { um2[j] = um1[j]; um1[j] = u0[j]; }
                if (lrow >= 0 || (c > 0 && c < NPCH)) {
                    const bf16_t* rp = proj + (size_t)(row0 + lrow) * PROJ_LD + ch0;
                    const u32x4 cv = *(const u32x4*)(rp + 1024), xv = *(const u32x4*)(rp + 2048);
#pragma unroll
                    for (int j = 0; j < 8; ++j) u0[j] = bfv(cv, j) * bfv(xv, j);
                } else if (c == 0) {
#pragma unroll
                    for (int j = 0; j < 8; ++j) u0[j] = 0.f;
                } else {
                    const float* hp = inp(p, 2) + (((size_t)layer * 8 + (c - NPCH)) * 2 + (2 + lrow)) * 1024 + ch0;
                    const f32x4 a = *(const f32x4*)hp, bb = *(const f32x4*)(hp + 4);
#pragma unroll
                    for (int j = 0; j < 4; ++j) { u0[j] = a[j]; u0[4 + j] = bb[j]; }
                }
                if (i >= 2) {
                    const int l = l0 + i - 2;
                    const u32x4 bv = *(const u32x4*)(proj + (size_t)(row0 + l) * PROJ_LD + ch0);
                    float y[8];
#pragma unroll
                    for (int j = 0; j < 8; ++j) y[j] = bfv(bv, j) * (w[0][j] * um2[j] + w[1][j] * um1[j] + w[2][j] * u0[j]);
                    u32x4 pk; pk.x = cvt_pk_bf16(y[0], y[1]); pk.y = cvt_pk_bf16(y[2], y[3]); pk.z = cvt_pk_bf16(y[4], y[5]); pk.w = cvt_pk_bf16(y[6], y[7]);
                    *(u32x4*)(mix + pg8::img_off(row0 + l, ch0, D_MIX / 64)) = pk;
                    if (last_chunk && l >= 62) {
                        float* op = (c < NPCH) ? p.out + O_SC_P + ((size_t)layer * 2 + (l - 62)) * 1024 + ch0
                                               : p.out + O_SC_S + (((size_t)layer * 8 + (c - NPCH)) * 2 + (l - 62)) * 1024 + ch0;
                        *(f32x4*)op = (f32x4){u0[0], u0[1], u0[2], u0[3]}; *(f32x4*)(op + 4) = (f32x4){u0[4], u0[5], u0[6], u0[7]};
                    }
                }
            }
        }
        __syncthreads();
        {
            const int hh = wave >> 1, half = wave & 1, h = g * 4 + hh;
            f32x4 acc[4][4];
#pragma unroll
            for (int a = 0; a < 4; ++a)
#pragma unroll
                for (int b = 0; b < 4; ++b) acc[a][b] = (f32x4){0.f, 0.f, 0.f, 0.f};
#pragma unroll
            for (int ks = 0; ks < 2; ++ks) {
                bf16x8 af[4], bfr[4];
#pragma unroll
                for (int a = 0; a < 4; ++a) af[a] = *(const bf16x8*)(s_BT + (half * 64 + a * 16 + fr) * 72 + ks * 32 + fq * 8);
#pragma unroll
                for (int b = 0; b < 4; ++b) bfr[b] = *(const bf16x8*)(s_xwT + (hh * 64 + b * 16 + fr) * 72 + ks * 32 + fq * 8);
#pragma unroll
                for (int a = 0; a < 4; ++a)
#pragma unroll
                    for (int b = 0; b < 4; ++b) acc[a][b] = __builtin_amdgcn_mfma_f32_16x16x32_bf16(af[a], bfr[b], acc[a][b], 0, 0, 0);
            }
            bf16_t* stp = ST + ((size_t)(c * 32 + h) * 64) * 128;
#pragma unroll
            for (int a = 0; a < 4; ++a)
#pragma unroll
                for (int b = 0; b < 4; ++b) {
                    u32x2 w; w.x = cvt_pk_bf16(acc[a][b][0], acc[a][b][1]); w.y = cvt_pk_bf16(acc[a][b][2], acc[a][b][3]);
                    *(u32x2*)(stp + (size_t)(b * 16 + fr) * 128 + half * 64 + a * 16 + fq * 4) = w;
                }
        }
        __syncthreads();
    }
}

__device__ void phase_s2(const Params& p, int layer) {
    unsigned* ST32 = (unsigned*)(p.ws + WS_ST);
    const float* DEC = (const float*)(p.ws + WS_DEC);
    constexpr int NP = 32 * 64 * 128 / 2;
    const int gtid = blockIdx.x * NTHREADS + opaque_tid(), nth = gridDim.x * NTHREADS;
    for (int idx = gtid; idx < NP; idx += nth) {
        const int h = idx >> 12;
        float s0 = 0.f, s1 = 0.f;
        for (int c0 = 0; c0 < NPCH; c0 += 16) {
            unsigned v[16]; float d[16];
#pragma unroll
            for (int j = 0; j < 16; ++j) { v[j] = ST32[(size_t)(c0 + j) * NP + idx]; d[j] = DEC[(c0 + j) * 32 + h]; }
#pragma unroll
            for (int j = 0; j < 16; ++j) {
                ST32[(size_t)(c0 + j) * NP + idx] = cvt_pk_bf16(s0, s1);
                s0 = s0 * d[j] + bf_lo(v[j]); s1 = s1 * d[j] + bf_hi(v[j]);
            }
        }
        *(f32x2*)(p.out + O_SSM_P + (size_t)layer * 262144 + 2 * (size_t)idx) = (f32x2){s0, s1};
    }
    for (int it = gtid; it < 8 * NP; it += nth) {
        const int b = it / NP, idx = it % NP, h = idx >> 12;
        const f32x2 s = *(const f32x2*)(inp(p, 4) + ((size_t)layer * 8 + b) * 262144 + 2 * (size_t)idx);
        const unsigned v = ST32[(size_t)(NPCH + b) * NP + idx];
        const float d = DEC[(NPCH + b) * 32 + h];
        ST32[(size_t)(NPCH + b) * NP + idx] = cvt_pk_bf16(s[0], s[1]);
        *(f32x2*)(p.out + O_SSM_S + ((size_t)layer * 8 + b) * 262144 + 2 * (size_t)idx) = (f32x2){s[0] * d + bf_lo(v), s[1] * d + bf_hi(v)};
    }
}

__device__ void phase_s3(const Params& p, int layer, unsigned char* lds) {
    bf16_t* s_xsT = (bf16_t*)lds;
    bf16_t* s_B = (bf16_t*)(lds + 36864);
    bf16_t* s_C = (bf16_t*)(lds + 36864 + 17408);
    bf16_t* s_M = (bf16_t*)(lds + 71680);
    float* s_dt = (float*)(lds + 108544);
    float* s_acum = s_dt + 256;
    float* s_ssq = s_acum + 256;
    const int tid = opaque_tid(), lane = tid & 63, wave = tid >> 6, fr = lane & 15, fq = lane >> 4;
    const bf16_t* proj = (const bf16_t*)(p.ws + WS_PROJ);
    bf16_t* mix = (bf16_t*)(p.ws + WS_MIX);
    const bf16_t* ST = (const bf16_t*)(p.ws + WS_ST);
    const float* hist = inp(p, 3) + (size_t)layer * 8 * 3 * 4096;
    for (int unit = blockIdx.x; unit < NCHUNK * 8; unit += gridDim.x) {
        const int c = unit >> 3, g = unit & 7, row0 = c * 64;
        const bool last_chunk = (c >= NPCH - 1);
        if (wave < 4) {
            const int h = g * 4 + wave; float dtv, acum, total;
            dt_acum(p, layer, c, h, lane, dtv, acum, total);
            s_dt[wave * 64 + lane] = dtv; s_acum[wave * 64 + lane] = acum;
        }
        {
            const int rr = tid & 7, cg = tid >> 3, l0 = rr * 8;
            const int col = (cg < 32) ? g * 256 + cg * 8 : (cg < 48 ? 2048 + g * 128 + (cg - 32) * 8 : 3072 + g * 128 + (cg - 48) * 8);
            u32x4 rows[11];
#pragma unroll
            for (int i = 0; i < 11; ++i) rows[i] = fetch_xbc8(proj, hist, c, l0 - 3 + i, col);
            const float* cw = inp(p, 12) + (size_t)layer * 4 * 4096 + col; const float* cb = inp(p, 13) + (size_t)layer * 4096 + col;
            float w[4][8], b[8];
#pragma unroll
            for (int k = 0; k < 4; ++k) { const f32x4 a = *(const f32x4*)(cw + k * 4096), bb = *(const f32x4*)(cw + k * 4096 + 4);
#pragma unroll
                for (int j = 0; j < 4; ++j) { w[k][j] = a[j]; w[k][4 + j] = bb[j]; } }
            { const f32x4 a = *(const f32x4*)cb, bb = *(const f32x4*)(cb + 4);
#pragma unroll
              for (int j = 0; j < 4; ++j) { b[j] = a[j]; b[4 + j] = bb[j]; } }
            if (last_chunk && rr == 7) {
#pragma unroll
                for (int i = 0; i < 3; ++i) {
                    float* op = (c < NPCH) ? p.out + O_CONV_P + ((size_t)layer * 3 + i) * 4096 + col
                                           : p.out + O_CONV_S + (((size_t)layer * 8 + (c - NPCH)) * 3 + i) * 4096 + col;
                    const u32x4 rv = rows[8 + i];
                    *(f32x4*)op = (f32x4){bf_lo(rv.x), bf_hi(rv.x), bf_lo(rv.y), bf_hi(rv.y)}; *(f32x4*)(op + 4) = (f32x4){bf_lo(rv.z), bf_hi(rv.z), bf_lo(rv.w), bf_hi(rv.w)};
                }
            }
            if (cg < 32) {
#pragma unroll
                for (int j = 0; j < 8; ++j) {
                    float o[8];
#pragma unroll
                    for (int i = 0; i < 8; ++i) {
                        float v = b[j];
#pragma unroll
                        for (int k = 0; k < 4; ++k) v += w[k][j] * bfv(rows[i + k], j);
                        o[i] = silu_f(v);
                    }
                    u32x4 pk; pk.x = cvt_pk_bf16(o[0], o[1]); pk.y = cvt_pk_bf16(o[2], o[3]); pk.z = cvt_pk_bf16(o[4], o[5]); pk.w = cvt_pk_bf16(o[6], o[7]);
                    *(u32x4*)(s_xsT + (cg * 8 + j) * 72 + l0) = pk;
                }
            } else {
                bf16_t* dst = (cg < 48) ? s_B + (cg - 32) * 8 : s_C + (cg - 48) * 8;
#pragma unroll
                for (int i = 0; i < 8; ++i) {
                    float o[8];
#pragma unroll
                    for (int j = 0; j < 8; ++j) {
                        float v = b[j];
#pragma unroll
                        for (int k = 0; k < 4; ++k) v += w[k][j] * bfv(rows[i + k], j);
                        o[j] = silu_f(v);
                    }
                    u32x4 pk; pk.x = cvt_pk_bf16(o[0], o[1]); pk.y = cvt_pk_bf16(o[2], o[3]); pk.z = cvt_pk_bf16(o[4], o[5]); pk.w = cvt_pk_bf16(o[6], o[7]);
                    *(u32x4*)(dst + (l0 + i) * 136) = pk;
                }
            }
        }
        __syncthreads();
        const int hh_y = wave >> 1, half_y = wave & 1, h_y = g * 4 + hh_y;
        u32x2 zv[2][4];
#pragma unroll
        for (int lti = 0; lti < 2; ++lti)
#pragma unroll
            for (int pt = 0; pt < 4; ++pt) zv[lti][pt] = *(const u32x2*)(proj + (size_t)(row0 + (2 * half_y + lti) * 16 + fr) * PROJ_LD + 3072 + h_y * 64 + pt * 16 + fq * 4);
        bf16x8 aPall[4][4];
        {
            const bf16_t* prev = ST + ((size_t)(c * 32 + h_y) * 64) * 128;
#pragma unroll
            for (int ks = 0; ks < 4; ++ks)
#pragma unroll
                for (int pt = 0; pt < 4; ++pt) aPall[ks][pt] = *(const bf16x8*)(prev + (size_t)(pt * 16 + fr) * 128 + ks * 32 + fq * 8);
        }
        {
            const int lt = wave >> 1;
#pragma unroll
            for (int sti = 0; sti < 2; ++sti) {
                const int st = (wave & 1) * 2 + sti;
                f32x4 acc = (f32x4){0.f, 0.f, 0.f, 0.f};
                if (st <= lt) {
#pragma unroll
                    for (int ks = 0; ks < 4; ++ks) {
                        const bf16x8 a = *(const bf16x8*)(s_C + (lt * 16 + fr) * 136 + ks * 32 + fq * 8);
                        const bf16x8 b = *(const bf16x8*)(s_B + (st * 16 + fr) * 136 + ks * 32 + fq * 8);
                        acc = __builtin_amdgcn_mfma_f32_16x16x32_bf16(a, b, acc, 0, 0, 0);
                    }
                }
                const int s = st * 16 + fr;
#pragma unroll
                for (int hh = 0; hh < 4; ++hh) {
                    const float as = s_acum[hh * 64 + s], ds = s_dt[hh * 64 + s], Dh = inp(p, 16)[layer * 32 + g * 4 + hh];
#pragma unroll
                    for (int r = 0; r < 4; ++r) {
                        const int l = lt * 16 + fq * 4 + r;
                        float v = 0.f;
                        if (s <= l) v = acc[r] * __expf(s_acum[hh * 64 + l] - as) * ds;
                        if (s == l) v += Dh;
                        s_M[(hh * 64 + l) * 72 + s] = (bf16_t)(cvt_pk_bf16(v, 0.f) & 0xffffu);
                    }
                }
            }
        }
        __syncthreads();
        {
            const int hh = wave >> 1, half = wave & 1, h = g * 4 + hh;
            f32x4 acc1[2][4], acc2[2][4];
#pragma unroll
            for (int a = 0; a < 2; ++a)
#pragma unroll
                for (int b = 0; b < 4; ++b) { acc1[a][b] = (f32x4){0.f, 0.f, 0.f, 0.f}; acc2[a][b] = (f32x4){0.f, 0.f, 0.f, 0.f}; }
#pragma unroll
            for (int ks = 0; ks < 4; ++ks) {
                bf16x8 bC[2];
#pragma unroll
                for (int lti = 0; lti < 2; ++lti) bC[lti] = *(const bf16x8*)(s_C + ((2 * half + lti) * 16 + fr) * 136 + ks * 32 + fq * 8);
#pragma unroll
                for (int lti = 0; lti < 2; ++lti)
#pragma unroll
                    for (int pt = 0; pt < 4; ++pt) acc2[lti][pt] = __builtin_amdgcn_mfma_f32_16x16x32_bf16(aPall[ks][pt], bC[lti], acc2[lti][pt], 0, 0, 0);
            }
#pragma unroll
            for (int ks = 0; ks < 2; ++ks) {
                bf16x8 bM[2], aX[4];
#pragma unroll
                for (int lti = 0; lti < 2; ++lti) bM[lti] = *(const bf16x8*)(s_M + (hh * 64 + (2 * half + lti) * 16 + fr) * 72 + ks * 32 + fq * 8);
#pragma unroll
                for (int pt = 0; pt < 4; ++pt) aX[pt] = *(const bf16x8*)(s_xsT + (hh * 64 + pt * 16 + fr) * 72 + ks * 32 + fq * 8);
#pragma unroll
                for (int lti = 0; lti < 2; ++lti)
#pragma unroll
                    for (int pt = 0; pt < 4; ++pt) acc1[lti][pt] = __builtin_amdgcn_mfma_f32_16x16x32_bf16(aX[pt], bM[lti], acc1[lti][pt], 0, 0, 0);
            }
#pragma unroll
            for (int lti = 0; lti < 2; ++lti) {
                const int l = (2 * half + lti) * 16 + fr;
                const float e = __expf(s_acum[hh * 64 + l]);
                float ss = 0.f;
#pragma unroll
                for (int pt = 0; pt < 4; ++pt) {
                    const float z0 = bf_lo(zv[lti][pt].x), z1 = bf_hi(zv[lti][pt].x), z2 = bf_lo(zv[lti][pt].y), z3 = bf_hi(zv[lti][pt].y);
                    f32x4 u = acc1[lti][pt] + e * acc2[lti][pt];
                    u[0] *= silu_f(z0); u[1] *= silu_f(z1); u[2] *= silu_f(z2); u[3] *= silu_f(z3);
                    acc1[lti][pt] = u;
                    ss += u[0] * u[0] + u[1] * u[1] + u[2] * u[2] + u[3] * u[3];
                }
                ss += __shfl_xor(ss, 16); ss += __shfl_xor(ss, 32);
                if (fq == 0) s_ssq[hh * 64 + l] = ss;
            }
            __syncthreads();
            const float* nw = inp(p, 17) + (size_t)layer * 2048 + h * 64;
#pragma unroll
            for (int lti = 0; lti < 2; ++lti) {
                const int l = (2 * half + lti) * 16 + fr;
                const float scale = rsqrtf(((s_ssq[l] + s_ssq[64 + l]) + (s_ssq[128 + l] + s_ssq[192 + l])) * (1.f / 256.f) + EPS);
#pragma unroll
                for (int pt = 0; pt < 4; ++pt) {
                    const f32x4 w4 = *(const f32x4*)(nw + pt * 16 + fq * 4);
                    const f32x4 o = acc1[lti][pt] * scale * w4;
                    u32x2 w; w.x = cvt_pk_bf16(o[0], o[1]); w.y = cvt_pk_bf16(o[2], o[3]);
                    *(u32x2*)(mix + pg8::img_off(row0 + l, 1024 + h * 64 + pt * 16 + fq * 4, D_MIX / 64)) = w;
                }
            }
        }
        __syncthreads();
    }
}

#define XB_TMO      128
#define XB_XCNT(j)  (256  + 64 * (j))
#define XB_XSUB(j)  (1280 + 64 * (j))
#define XB_XGEN(j)  (2304 + 64 * (j))
#define XB_TOP      3328
#define XB_TOPGEN   3392
#define XCD_BAR_WORDS 3456
#define XB_SPIN_CAP (1u << 18)

__device__ __forceinline__ unsigned xb_ld(unsigned* p)              { return __hip_atomic_load(p, __ATOMIC_RELAXED, __HIP_MEMORY_SCOPE_AGENT); }
__device__ __forceinline__ unsigned xb_add(unsigned* p, unsigned v) { return __hip_atomic_fetch_add(p, v, __ATOMIC_RELAXED, __HIP_MEMORY_SCOPE_AGENT); }
__device__ __forceinline__ unsigned xb_xcc_id() { return (unsigned)__builtin_amdgcn_s_getreg((3 << 11) | 20) & 0xFu; }
#define XB_SPIN(cond, bar) do { unsigned _sp = 0; while (cond) { __builtin_amdgcn_s_sleep(1); \
    if ((++_sp & 255u) == 0u) { if (xb_ld(&(bar)[XB_TMO])) break; if (_sp > XB_SPIN_CAP) { atomicAdd(&(bar)[XB_TMO], 1u); break; } } } } while (0)

struct XcdBarrier {
    unsigned* bar; unsigned x;
    volatile LAS unsigned* st;
};

__device__ __forceinline__ XcdBarrier xcd_barrier_post(unsigned* bar, volatile LAS unsigned* st) {
    XcdBarrier b; b.bar = bar; b.x = xb_xcc_id(); b.st = st;
    if (threadIdx.x == 0) (void)xb_add(&bar[XB_XCNT(b.x)], 1u);
    return b;
}
__device__ __forceinline__ void xcd_barrier_complete(unsigned* bar, unsigned x, unsigned& nloc, unsigned& nx) {
    const unsigned G = gridDim.x * gridDim.y * gridDim.z;
    unsigned sum, cnt, mine, sp = 0u;
    for (;;) {
        sum = 0u; cnt = 0u; mine = 0u;
#pragma unroll
        for (unsigned j = 0; j < 16; ++j) { const unsigned c = xb_ld(&bar[XB_XCNT(j)]); sum += c; cnt += (c > 0u) ? 1u : 0u; mine = (j == x) ? c : mine; }
        if (sum == G) break;
        __builtin_amdgcn_s_sleep(1);
        if ((++sp & 255u) == 0u) { if (xb_ld(&bar[XB_TMO])) break; if (sp > XB_SPIN_CAP) { atomicAdd(&bar[XB_TMO], 1u); break; } }
    }
    nloc = mine > 0u ? mine : 1u; nx = cnt > 0u ? cnt : 1u;
}

__device__ __forceinline__ void xcd_barrier(const XcdBarrier& b) {
    asm volatile("s_waitcnt vmcnt(0)" ::: "memory");
    __syncthreads();
    if (threadIdx.x == 0) {
        unsigned* bar = b.bar;
        __builtin_amdgcn_s_waitcnt(0);
        unsigned nloc = b.st[0], nx = b.st[1];
        if (nloc == 0u) { xcd_barrier_complete(bar, b.x, nloc, nx); b.st[0] = nloc; b.st[1] = nx; }
        const unsigned old = xb_add(&bar[XB_XSUB(b.x)], 1u);
        const unsigned gen = old / nloc;
        if (old + 1u == (gen + 1u) * nloc) {
            __builtin_amdgcn_fence(__ATOMIC_RELEASE, "agent");
            asm volatile("s_waitcnt vmcnt(0)" ::: "memory");
            const unsigned og = xb_add(&bar[XB_TOP], 1u);
            const unsigned tg = og / nx;
            if (og + 1u == (tg + 1u) * nx) xb_add(&bar[XB_TOPGEN], 1u);
            else XB_SPIN(xb_ld(&bar[XB_TOPGEN]) == tg, bar);
            __builtin_amdgcn_fence(__ATOMIC_ACQUIRE, "agent");
            xb_add(&bar[XB_XGEN(b.x)], 1u);
            asm volatile("s_waitcnt vmcnt(0)" ::: "memory");
        } else {
            XB_SPIN(xb_ld(&bar[XB_XGEN(b.x)]) == gen, bar);
            __builtin_amdgcn_fence(__ATOMIC_ACQUIRE, "agent");
            asm volatile("s_waitcnt vmcnt(0)" ::: "memory");
        }
    }
    __syncthreads();
}

#ifndef PROG_LIST
#define PROG_LIST 0,1,2,3,4,5,6,7,8,9,10,11,12,13,14,15,16,17,18,19,20,21,22,23,24
#endif
__constant__ int PROG[] = {PROG_LIST};

__global__ void __launch_bounds__(NTHREADS, 2) fwd_kernel(Params p) {
    extern __shared__ __attribute__((aligned(16))) unsigned char lds_raw[];
    LAS unsigned char* lds = (LAS unsigned char*)lds_raw;
    float* X = (float*)(p.ws + WS_X); bf16_t* H = (bf16_t*)(p.ws + WS_H); bf16_t* ACT = (bf16_t*)(p.ws + WS_PROJ); bf16_t* PROJ = (bf16_t*)(p.ws + WS_PROJ);
    bf16_t* MIX = (bf16_t*)(p.ws + WS_MIX); float* DT = (float*)(p.ws + WS_DT);
    float* PART = (float*)(p.ws + WS_ST);
    const int G = gridDim.x, cblk = blockIdx.x;
    { volatile LAS unsigned* stw = (volatile LAS unsigned*)(lds + 131072); if (threadIdx.x < 4) stw[threadIdx.x] = 0u; }
    __syncthreads();
    const XcdBarrier xbar = xcd_barrier_post((unsigned*)(p.ws + WS_CTL), (volatile LAS unsigned*)(lds + 131072));
    for (int pi = p.ph_lo; pi < p.ph_hi; ++pi) {
        const int ph = PROG[pi];
        if (ph == 0) {
            phase_convert(p, lds_raw);
            phase_norm<0>(p, inp(p, 5), 0, 0.f);
        } else {
            const int layer = (ph - 1) / 12, sub = (ph - 1) % 12;
            unsigned char* wl = p.ws + (size_t)layer * SZ_LAYERW;
            if (sub == 0 || sub == 9) {
                pg8::Gemm g{H, (const bf16_t*)(wl + (sub == 0 ? OFF_WGU1 : OFF_WGU2)), M_ROWS, 11264, H_LD, 2048};
                typedef pg8::SplitOrder<M_ROWS, 11264, 1, 2048> SO; SO S; S.init(G, cblk);
                pg8::EpiSwiglu E{ACT};
                pg8::gemm_phase<pg8::EpiSwiglu, SO, H_LD>(lds, g, S, E);
                if (G == 256 && cblk >= 216 && (layer == 0 || sub == 0)) convert_deferred(p, (layer == 0 ? (sub == 0 ? DEF_G1A : DEF_G1B) : DEF2_G1A) + (cblk - 216) * 6, 6);
            } else if (sub == 1 || sub == 10) {
                pg8::Gemm g{ACT, (const bf16_t*)(wl + (sub == 1 ? OFF_WD1 : OFF_WD2)), M_ROWS, 2048, ACT_LD, D_FF};
                typedef pg8::MixedOrder<D_FF, 11> SO; SO S; S.init(G, cblk);
                pg8::EpiAtomic E{X, PART, 0.5f};
                pg8::gemm_phase<pg8::EpiAtomic, SO, ACT_LD>(lds, g, S, E);
            } else if (sub == 7) {
                pg8::Gemm g{MIX, (const bf16_t*)(wl + OFF_WOUT), M_ROWS, 2048, MIX_LD, D_MIX};
                typedef pg8::MixedOrder<D_MIX, 12> SO; SO S; S.init(G, cblk);
                pg8::EpiAtomic E{X, PART, 1.0f};
                pg8::gemm_phase<pg8::EpiAtomic, SO, MIX_LD>(lds, g, S, E);
            } else if (sub == 2 || sub == 8) {
                if (sub == 2) phase_norm<1>(p, inp(p, 9) + (size_t)layer * 2048, 11, 0.5f);
                else phase_norm<1>(p, inp(p, 19) + (size_t)layer * 2048, 12, 1.0f);
            } else if (sub == 3) {
                pg8::Gemm g{H, (const bf16_t*)(wl + OFF_WIN), M_ROWS, N_IN_PAD, H_LD, 2048};
                typedef pg8::SplitOrder<M_ROWS, N_IN_PAD, 1, 2048> SO; SO S; S.init(G, cblk);
                pg8::EpiProj E{PROJ, DT};
                pg8::gemm_phase<pg8::EpiProj, SO, H_LD>(lds, g, S, E);
                if (G == 256 && cblk >= 234) convert_deferred(p, (layer == 0 ? DEF_G3 : DEF2_G3) + (cblk - 234) * 6, 6);
            } else if (sub == 4) {
                phase_s1(p, layer, lds_raw);
                if (G == 256 && cblk >= 64) convert_deferred(p, (layer == 0 ? DEF_S1 : DEF2_S1) + (cblk - 64), 1);
            } else if (sub == 5) {
                phase_s2(p, layer);
            } else if (sub == 6) {
                phase_s3(p, layer, lds_raw);
                if (G == 256 && cblk >= 64) convert_deferred(p, (layer == 0 ? DEF_S3 : DEF2_S3) + (cblk - 64), 1);
            } else {
                if (layer == 0) phase_norm<1>(p, inp(p, 5) + 2048, 11, 0.5f);
                else phase_norm<2>(p, inp(p, 23), 11, 0.5f);
            }
        }
        if (pi + 1 < p.ph_hi) {
            if (p.ph_hi > 4096) cg::this_grid().sync();
            xcd_barrier(xbar);
        }
    }
}

#ifndef PROG_LIST
#error
#endif
static const int prog_host[] = {PROG_LIST};
#define NPROG_HOST ((int)(sizeof(prog_host) / sizeof(int)))
extern "C" void kernel_launch(void* const* d_in, const int* in_sizes, int n_in, void* d_out, int out_size, void* d_ws, size_t ws_size, hipStream_t stream) {
    static int grid = 0;
    if (grid == 0) {
        int dev = 0, cus = 0, per_cu = 0;
        hipGetDevice(&dev);
        hipDeviceGetAttribute(&cus, hipDeviceAttributeMultiprocessorCount, dev);
        if (hipFuncSetAttribute((const void*)fwd_kernel, hipFuncAttributeMaxDynamicSharedMemorySize, LDS_BYTES) != hipSuccess) fprintf(stderr, "kernel_launch: hipFuncSetAttribute failed\n");
        if (hipOccupancyMaxActiveBlocksPerMultiprocessor(&per_cu, (const void*)fwd_kernel, NTHREADS, LDS_BYTES) != hipSuccess || per_cu < 1) { fprintf(stderr, "kernel_launch: occupancy query says %d\n", per_cu); per_cu = 1; }
        (void)hipGetLastError();
        if (per_cu > 1) per_cu = 1;
        grid = cus * per_cu;
        if (ws_size < WS_END) fprintf(stderr, "kernel_launch: workspace too small: %zu < %zu\n", ws_size, (size_t)WS_END);
    }
    Params p{};
    for (int i = 0; i < 24; ++i) p.in[i] = (const float*)d_in[i];
    p.out = (float*)d_out; p.ws = (unsigned char*)d_ws;
#if ONE_LAUNCH
    hipMemsetAsync((unsigned char*)d_ws + WS_CTL, 0, 16384, stream);
    p.ph_lo = 0; p.ph_hi = NPROG_HOST;
    void* args[] = {&p};
    hipError_t e = hipLaunchCooperativeKernel((const void*)fwd_kernel, dim3(grid), dim3(NTHREADS), args, LDS_BYTES, stream);
    if (e != hipSuccess) fprintf(stderr, "cooperative launch failed: %s (grid %d)\n", hipGetErrorString(e), grid);
#else
#ifndef PH_LIST
#define PH_LIST 0,1,2,3,4,5,6,7,8,9,10,11,12,13,14,15,16,17,18,19,20,21,22,23,24
#endif
    const int phl[] = {PH_LIST};
    for (int ph : phl) {
        p.ph_lo = ph; p.ph_hi = ph + 1;
        hipLaunchKernelGGL(fwd_kernel, dim3(grid), dim3(NTHREADS), LDS_BYTES, stream, p);
    }
#endif
}
```

```cpp
#include <hip/hip_runtime.h>
#include <hip/hip_cooperative_groups.h>
#include <cstdio>
namespace cg = cooperative_groups;

#ifndef ONE_LAUNCH
#define ONE_LAUNCH 1
#endif

#define LAS __attribute__((address_space(3)))
typedef unsigned short bf16_t;
typedef short bf16x8 __attribute__((ext_vector_type(8)));
typedef float f32x4 __attribute__((ext_vector_type(4)));
typedef float f32x2 __attribute__((ext_vector_type(2)));
typedef unsigned u32x4 __attribute__((ext_vector_type(4)));
typedef unsigned u32x2 __attribute__((ext_vector_type(2)));

constexpr int D_MODEL = 2048, M_ROWS = 8704, NCHUNK = 136, NPCH = 128;
constexpr int D_FF = 5632, PROJ_LD = 9216, N_IN = 9248, N_IN_PAD = 9472, D_MIX = 3072;
constexpr int H_LD = 2048, ACT_LD = D_FF, MIX_LD = D_MIX;
constexpr float EPS = 1e-6f;
constexpr int NTHREADS = 512;
constexpr int LDS_BYTES = 131072 + 16;

constexpr size_t O_SC_P = 17825792, O_CONV_P = 17829888, O_SSM_P = 17854464, O_SC_S = 18378752, O_CONV_S = 18411520, O_SSM_S = 18608128;

constexpr size_t SZ_WGU = (size_t)11264 * H_LD * 2, SZ_WD = (size_t)2048 * ACT_LD * 2, SZ_WIN = (size_t)N_IN_PAD * H_LD * 2, SZ_WOUT = (size_t)2048 * MIX_LD * 2;
constexpr size_t OFF_WGU1 = 0, OFF_WD1 = SZ_WGU, OFF_WIN = SZ_WGU + SZ_WD, OFF_WOUT = OFF_WIN + SZ_WIN, OFF_WGU2 = OFF_WOUT + SZ_WOUT, OFF_WD2 = OFF_WGU2 + SZ_WGU;
constexpr size_t SZ_LAYERW = 2 * SZ_WGU + 2 * SZ_WD + SZ_WIN + SZ_WOUT;
constexpr size_t WS_X = 2 * SZ_LAYERW;
constexpr size_t WS_H = WS_X + (size_t)M_ROWS * 2048 * 4;
constexpr size_t WS_PROJ = WS_H + (size_t)M_ROWS * H_LD * 2;
constexpr size_t WS_MIX = WS_PROJ + (size_t)M_ROWS * PROJ_LD * 2;
constexpr size_t WS_ST = WS_MIX + (size_t)M_ROWS * MIX_LD * 2;
constexpr size_t WS_DT = WS_ST + (size_t)NCHUNK * 32 * 64 * 128 * 2;
constexpr size_t WS_DEC = WS_DT + (size_t)M_ROWS * 32 * 4;
constexpr size_t WS_CTL = WS_DEC + (size_t)NCHUNK * 32 * 4;
constexpr size_t WS_END = WS_CTL + 16384;

struct Params { const float* in[24]; float* out; unsigned char* ws; int ph_lo, ph_hi; };

__device__ __forceinline__ const float* inp(const Params& p, int i) { asm volatile("" : "+s"(i)); return p.in[i]; }
__device__ __forceinline__ float bf_lo(unsigned u) { return __uint_as_float(u << 16); }
__device__ __forceinline__ float bf_hi(unsigned u) { return __uint_as_float(u & 0xffff0000u); }
typedef __bf16 bf16x2v __attribute__((ext_vector_type(2)));
__device__ __forceinline__ unsigned cvt_pk_bf16(float lo, float hi) { f32x2 v = {lo, hi}; bf16x2v b = __builtin_convertvector(v, bf16x2v); return __builtin_bit_cast(unsigned, b); }
__device__ __forceinline__ float silu_f(float x) { return x * __builtin_amdgcn_rcpf(1.f + __expf(-x)); }
__device__ __forceinline__ float softplus_f(float x) { return x > 20.f ? x : log1pf(expf(x)); }
__device__ __forceinline__ int opaque_tid() { int t = threadIdx.x; asm volatile("" : "+v"(t)); return t; }
__device__ __forceinline__ float bfv(const u32x4& v, int j) { const unsigned w = v[j >> 1]; return (j & 1) ? bf_hi(w) : bf_lo(w); }

namespace pg8 {
constexpr int BM = 256, BK = 64, HALF = 128, HTB = HALF * BK * 2, STAGE_BYTES = 8 * HTB, NXCD = 8, WGM = 8;
__host__ __device__ __forceinline__ int lds_byte(int r, int c) { const int st = (r >> 4) * 2 + (c >> 5), rr = r & 15, cc = c & 31, ob = rr * 64 + cc * 2; return st * 1024 + (ob ^ (((ob >> 9) & 1) << 5)); }
__host__ __device__ __forceinline__ void stage_rc(int b, int& R, int& C) { const int st = b / 1024, sb = b % 1024, swz = sb ^ (((sb >> 9) & 1) << 5); R = (st >> 1) * 16 + swz / 64; C = (st & 1) * 32 + (swz % 64) / 2; }
__host__ __device__ __forceinline__ int perm32(int rho) { const int n = rho >> 4, i = rho & 15; return 8 * (i >> 2) + 4 * n + (i & 3); }

__host__ __device__ __forceinline__ int perm32_inv(int s) { return 16 * ((s >> 2) & 1) + 4 * (s >> 3) + (s & 3); }
__device__ __forceinline__ size_t img_off(int row, int col, int KT) {
    return ((size_t)((row >> 8) * KT + (col >> 6)) << 14) + (size_t)(((row >> 7) & 1) << 13) + (size_t)(lds_byte(row & 127, col & 63) >> 1);
}
struct Unit { int pm, pn, kofs, nt, part; };
struct Gemm { const bf16_t* A; const bf16_t* Bt; int M, N, ld, Kc; };

template <int M, int N, int KS, int Kc>
struct SplitOrder {
    static constexpr int nM = M / BM, nN = N / BM, nwg = nM * nN;
    int G, c;
    __device__ void init(int G_, int c_) { G = G_; c = c_; }
    __device__ bool next(int i, Unit& u) const {
        const int L = i * G + c; if (L >= nwg * KS) return false;
        const int ks = L / nwg; int wgid = L - ks * nwg;
        { const int q = nwg / NXCD, r = nwg % NXCD, xcd = wgid % NXCD, off = wgid / NXCD; wgid = (xcd < r ? xcd * (q + 1) : r * (q + 1) + (xcd - r) * q) + off; }
        const int nig = WGM * nN, gid = wgid / nig, fm = gid * WGM, gsz = (nM - fm) < WGM ? (nM - fm) : WGM;
        u.pm = fm + ((wgid % nig) % gsz); u.pn = (wgid % nig) / gsz; u.kofs = ks * Kc; u.nt = Kc / BK; u.part = -1; return true;
    }
};


template <int K, int KS>
struct MixedOrder {
    static constexpr int nFull = 256, KcP = K / KS;
    int G, c;
    __device__ void init(int G_, int c_) { G = G_; c = c_; }
    __device__ bool next(int i, Unit& u) const {
        const int L = i * G + c;
        if (L < nFull) {
            int wgid = L; { const int q = nFull / NXCD, xcd = wgid % NXCD, off = wgid / NXCD; wgid = xcd * q + off; }
            const int nig = WGM * 8, gid = wgid / nig, fm = gid * WGM;
            u.pm = fm + ((wgid % nig) % WGM); u.pn = (wgid % nig) / WGM; u.kofs = 0; u.nt = K / BK; u.part = -1; return true;
        }
        const int q = L - nFull; if (q >= 16 * KS) return false;
        const int tile = q / KS, ks = q - tile * KS;
        u.pm = 32 + (tile >> 3); u.pn = tile & 7; u.kofs = ks * KcP; u.nt = KcP / BK; u.part = ks; return true;
    }
};

struct EpiSwiglu {
    static constexpr bool PERM = true;
    bf16_t* O;
    __device__ __forceinline__ void operator()(const f32x4 (&acc)[2][2][4][2], const Unit& u, int wr, int wc, int fr, int fq) const {
        const int row0 = u.pm * BM + wr * 64 + fr, col0 = u.pn * 128 + wc * 32 + 8 * fq;
#pragma unroll
        for (int ai = 0; ai < 2; ++ai)
#pragma unroll
            for (int m = 0; m < 4; ++m) {
                bf16_t* rowp = O + img_off(row0 + ai * HALF + m * 16, col0, D_FF / 64);
                const f32x4 g0 = acc[ai][0][m][0], g1 = acc[ai][0][m][1], u0 = acc[ai][1][m][0], u1 = acc[ai][1][m][1];
                u32x4 w;
                w.x = cvt_pk_bf16(silu_f(g0[0]) * u0[0], silu_f(g0[1]) * u0[1]); w.y = cvt_pk_bf16(silu_f(g0[2]) * u0[2], silu_f(g0[3]) * u0[3]);
                w.z = cvt_pk_bf16(silu_f(g1[0]) * u1[0], silu_f(g1[1]) * u1[1]); w.w = cvt_pk_bf16(silu_f(g1[2]) * u1[2], silu_f(g1[3]) * u1[3]);
                *(u32x4*)rowp = w;
            }
    }
};
struct EpiAtomic {
    static constexpr bool PERM = false;
    float* X; float* PART; float scale;
    __device__ __forceinline__ void operator()(const f32x4 (&acc)[2][2][4][2], const Unit& u, int wr, int wc, int fr, int fq) const {
        const int row0 = u.pm * BM + wr * 64 + fr, col0 = u.pn * BM + wc * 32 + 4 * fq;
        if (u.part < 0) {
#pragma unroll
            for (int ai = 0; ai < 2; ++ai)
#pragma unroll
                for (int m = 0; m < 4; ++m) {
                    float* rowp = X + (size_t)(row0 + ai * HALF + m * 16) * D_MODEL + col0;
                    f32x4 xv[2][2];
#pragma unroll
                    for (int bj = 0; bj < 2; ++bj)
#pragma unroll
                        for (int n = 0; n < 2; ++n) xv[bj][n] = *(const f32x4*)(rowp + bj * HALF + n * 16);
#pragma unroll
                    for (int bj = 0; bj < 2; ++bj)
#pragma unroll
                        for (int n = 0; n < 2; ++n) *(f32x4*)(rowp + bj * HALF + n * 16) = xv[bj][n] + scale * acc[ai][bj][m][n];
                }
        } else {
            float* base = PART + (size_t)u.part * (512 * 2048);
#pragma unroll
            for (int ai = 0; ai < 2; ++ai)
#pragma unroll
                for (int m = 0; m < 4; ++m) {
                    float* rowp = base + (size_t)(row0 - 8192 + ai * HALF + m * 16) * D_MODEL + col0;
#pragma unroll
                    for (int bj = 0; bj < 2; ++bj)
#pragma unroll
                        for (int n = 0; n < 2; ++n) *(f32x4*)(rowp + bj * HALF + n * 16) = acc[ai][bj][m][n];
                }
        }
    }
};
struct EpiProj {
    static constexpr bool PERM = true;
    bf16_t* P; float* DT;
    __device__ __forceinline__ void operator()(const f32x4 (&acc)[2][2][4][2], const Unit& u, int wr, int wc, int fr, int fq) const {
        const int row0 = u.pm * BM + wr * 64 + fr;
        if (u.pn < 36) {
            const int col0 = u.pn * BM + wc * 32 + 8 * fq;
#pragma unroll
            for (int ai = 0; ai < 2; ++ai)
#pragma unroll
                for (int m = 0; m < 4; ++m) {
                    bf16_t* rowp = P + (size_t)(row0 + ai * HALF + m * 16) * PROJ_LD + col0;
#pragma unroll
                    for (int bj = 0; bj < 2; ++bj) {
                        const f32x4 v0 = acc[ai][bj][m][0], v1 = acc[ai][bj][m][1];
                        u32x4 w; w.x = cvt_pk_bf16(v0[0], v0[1]); w.y = cvt_pk_bf16(v0[2], v0[3]); w.z = cvt_pk_bf16(v1[0], v1[1]); w.w = cvt_pk_bf16(v1[2], v1[3]);
                        *(u32x4*)(rowp + bj * HALF) = w;
                    }
                }
        } else if (wc == 0) {
#pragma unroll
            for (int ai = 0; ai < 2; ++ai)
#pragma unroll
                for (int m = 0; m < 4; ++m) {
                    float* rowp = DT + (size_t)(row0 + ai * HALF + m * 16) * 32 + 8 * fq;
                    *(f32x4*)rowp = acc[ai][0][m][0]; *(f32x4*)(rowp + 4) = acc[ai][0][m][1];
                }
        }
    }
};

template <class Epi, class Sched, int LD>
__device__ __forceinline__ void gemm_phase(LAS unsigned char* lds, const Gemm g, const Sched& S, const Epi& E) {
    const int tid = opaque_tid(), wid = __builtin_amdgcn_readfirstlane(tid >> 6), lane = tid & 63, wr = wid >> 2, wc = wid & 3, fr = lane & 15, fq = lane >> 4;
    constexpr int K = LD;
    unsigned voffA[2], voffB[2];
#pragma unroll
    for (int i = 0; i < 2; ++i) { voffA[i] = (unsigned)(tid * 16 + i * 8192); voffB[i] = voffA[i]; }
    const size_t kstep = (size_t)(2 * HTB);
    const size_t hstep = (size_t)HTB;
    const size_t tstep = (size_t)(K / BK) * kstep;
    const unsigned ldsw = (unsigned)wid * 1024u;
    const int aoff = lds_byte(wr * 64 + fr, fq * 8), boff = lds_byte(wc * 32 + fr, fq * 8);
#define PG8_SA(b, h) (((b) * 2 + (h)) * HTB)
#define PG8_SB(b, h) ((4 + (b) * 2 + (h)) * HTB)
#define PG8_STAGE(bufoff, gbase, voff) do { _Pragma("unroll") for (int _i = 0; _i < 2; ++_i) \
        __builtin_amdgcn_global_load_lds((const unsigned*)((const char*)(gbase) + (voff)[_i]), (LAS unsigned*)(lds + (bufoff) + ldsw + _i * 8192), 16, 0, 0); } while (0)
#define PG8_LDA(dst, b, h) do { _Pragma("unroll") for (int m = 0; m < 4; ++m) _Pragma("unroll") for (int k = 0; k < 2; ++k) dst[m][k] = *(const LAS bf16x8*)(lds + PG8_SA(b, h) + aoff + m * 2048 + k * 1024); } while (0)
#define PG8_LDB(dst, b, h) do { _Pragma("unroll") for (int n = 0; n < 2; ++n) _Pragma("unroll") for (int k = 0; k < 2; ++k) dst[n][k] = *(const LAS bf16x8*)(lds + PG8_SB(b, h) + boff + n * 2048 + k * 1024); } while (0)
#define PG8_MMA(ai, bj, At, Bt) do { __builtin_amdgcn_s_setprio(1); _Pragma("unroll") for (int m = 0; m < 4; ++m) _Pragma("unroll") for (int n = 0; n < 2; ++n) _Pragma("unroll") for (int k = 0; k < 2; ++k) \
        acc[ai][bj][m][n] = __builtin_amdgcn_mfma_f32_16x16x32_bf16(Bt[n][k], At[m][k], acc[ai][bj][m][n], 0, 0, 0); __builtin_amdgcn_s_setprio(0); } while (0)
#define PG8_WAIT_V(n) asm volatile("s_waitcnt vmcnt(" #n ")" ::: "memory")
#define PG8_WAIT_L(n) asm volatile("s_waitcnt lgkmcnt(" #n ")" ::: "memory")
#define PG8_BAR __builtin_amdgcn_s_barrier()
#define PG8_SCHED __builtin_amdgcn_sched_barrier(0)
    Unit cur, nxt; int ui = 0;
    if (!S.next(0, cur)) return;
    f32x4 acc[2][2][4][2];
#pragma unroll
    for (int a = 0; a < 2; ++a)
#pragma unroll
        for (int b = 0; b < 2; ++b)
#pragma unroll
            for (int m = 0; m < 4; ++m)
#pragma unroll
                for (int n = 0; n < 2; ++n) acc[a][b][m][n] = (f32x4){0.f, 0.f, 0.f, 0.f};
    bf16x8 At[4][2], B0[2][2], B1[2][2];
    const char* cA = (const char*)g.A + (size_t)cur.pm * tstep + (size_t)(cur.kofs / BK) * kstep; const char* cB = (const char*)g.Bt + (size_t)cur.pn * tstep + (size_t)(cur.kofs / BK) * kstep;
    PG8_STAGE(PG8_SB(0, 0), cB, voffB); PG8_STAGE(PG8_SA(0, 0), cA, voffA); PG8_STAGE(PG8_SB(0, 1), cB + hstep, voffB); PG8_STAGE(PG8_SA(0, 1), cA + hstep, voffA);
    if (wr == 1) PG8_BAR;
    PG8_WAIT_V(4); PG8_BAR;
    PG8_STAGE(PG8_SB(1, 0), cB + kstep, voffB); PG8_STAGE(PG8_SA(1, 0), cA + kstep, voffA); PG8_STAGE(PG8_SB(1, 1), cB + hstep + kstep, voffB);
    PG8_WAIT_V(6); PG8_BAR;
    for (;;) {
        const bool has_next = S.next(ui + 1, nxt);
        const char* nA = has_next ? (const char*)g.A + (size_t)nxt.pm * tstep + (size_t)(nxt.kofs / BK) * kstep : cA; const char* nB = has_next ? (const char*)g.Bt + (size_t)nxt.pn * tstep + (size_t)(nxt.kofs / BK) * kstep : cB;
        const int nt = cur.nt;
        for (int t = 0; t < nt; t += 2) {
            const bool last = (t == nt - 2);
            const char* a1 = cA + (size_t)(t + 1) * kstep;
            const char* a2 = last ? nA : cA + (size_t)(t + 2) * kstep; const char* b2 = last ? nB : cB + (size_t)(t + 2) * kstep;
            const char* a3 = a2 + kstep; const char* b3 = b2 + kstep;
            PG8_LDB(B0, 0, 0); PG8_SCHED; PG8_LDA(At, 0, 0); PG8_STAGE(PG8_SA(1, 1), a1 + hstep, voffA);
            PG8_WAIT_L(8); PG8_BAR; PG8_WAIT_L(0); PG8_MMA(0, 0, At, B0); PG8_BAR; PG8_SCHED;
            PG8_LDB(B1, 0, 1); PG8_STAGE(PG8_SB(0, 0), b2, voffB);
            PG8_BAR; PG8_WAIT_L(0); PG8_MMA(0, 1, At, B1); PG8_BAR;
            PG8_LDA(At, 0, 1); PG8_STAGE(PG8_SA(0, 0), a2, voffA);
            PG8_BAR; PG8_WAIT_L(0); PG8_MMA(1, 0, At, B0); PG8_BAR; PG8_SCHED;
            PG8_STAGE(PG8_SB(0, 1), b2 + hstep, voffB);
            PG8_WAIT_V(6); PG8_BAR; PG8_MMA(1, 1, At, B1); PG8_BAR;
            PG8_LDB(B0, 1, 0); PG8_SCHED; PG8_LDA(At, 1, 0); PG8_STAGE(PG8_SA(0, 1), a2 + hstep, voffA);
            PG8_WAIT_L(8); PG8_BAR; PG8_WAIT_L(0); PG8_MMA(0, 0, At, B0); PG8_BAR; PG8_SCHED;
            PG8_LDB(B1, 1, 1); PG8_STAGE(PG8_SB(1, 0), b3, voffB);
            PG8_BAR; PG8_WAIT_L(0); PG8_MMA(0, 1, At, B1); PG8_BAR;
            PG8_LDA(At, 1, 1); PG8_STAGE(PG8_SA(1, 0), a3, voffA);
            PG8_BAR; PG8_WAIT_L(0); PG8_MMA(1, 0, At, B0); PG8_BAR; PG8_SCHED;
            PG8_STAGE(PG8_SB(1, 1), b3 + hstep, voffB);
            PG8_WAIT_V(6); PG8_BAR; PG8_MMA(1, 1, At, B1); PG8_BAR;
        }
        E(acc, cur, wr, wc, fr, fq);
        if (!has_next) break;
#pragma unroll
        for (int a = 0; a < 2; ++a)
#pragma unroll
            for (int b = 0; b < 2; ++b)
#pragma unroll
                for (int m = 0; m < 4; ++m)
#pragma unroll
                    for (int n = 0; n < 2; ++n) acc[a][b][m][n] = (f32x4){0.f, 0.f, 0.f, 0.f};
        cur = nxt; cA = nA; cB = nB; ++ui;
    }
    PG8_WAIT_V(0);
    if (wr == 0) PG8_BAR;
    PG8_BAR;
#undef PG8_SA
#undef PG8_SB
#undef PG8_STAGE
#undef PG8_LDA
#undef PG8_LDB
#undef PG8_MMA
#undef PG8_WAIT_V
#undef PG8_WAIT_L
#undef PG8_BAR
#undef PG8_SCHED
}
}

struct TileInfo { const float* src; bf16_t* dst; int K, N, k0, n0, mode, perm; };
constexpr int CONV_TILES_LAYER = 6 * 352 + 580 + 192;

__device__ __forceinline__ void conv_decode(const Params& p, int t, TileInfo& ti) {
    const int layer = t / CONV_TILES_LAYER; int r = t % CONV_TILES_LAYER;
    unsigned char* wl = p.ws + (size_t)layer * SZ_LAYERW;
    int ntn;
    if (r < 352)       { ti.src = inp(p, 6)  + (size_t)layer * 2048 * 5632; ti.dst = (bf16_t*)(wl + OFF_WGU1); ti.K = 2048; ti.N = 5632; ti.mode = 1; ti.perm = 1; ntn = 88; }
    else if (r < 704)  { r -= 352;  ti.src = inp(p, 7)  + (size_t)layer * 2048 * 5632; ti.dst = (bf16_t*)(wl + OFF_WGU1); ti.K = 2048; ti.N = 5632; ti.mode = 2; ti.perm = 1; ntn = 88; }
    else if (r < 1056) { r -= 704;  ti.src = inp(p, 8)  + (size_t)layer * 5632 * 2048; ti.dst = (bf16_t*)(wl + OFF_WD1);  ti.K = 5632; ti.N = 2048; ti.mode = 0; ti.perm = 0; ntn = 32; }
    else if (r < 1636) { r -= 1056; ti.src = inp(p, 10) + (size_t)layer * 2048 * N_IN; ti.dst = (bf16_t*)(wl + OFF_WIN);  ti.K = 2048; ti.N = N_IN; ti.mode = 0; ti.perm = 1; ntn = 145; }
    else if (r < 1828) { r -= 1636; ti.src = inp(p, 18) + (size_t)layer * 3072 * 2048; ti.dst = (bf16_t*)(wl + OFF_WOUT); ti.K = 3072; ti.N = 2048; ti.mode = 0; ti.perm = 0; ntn = 32; }
    else if (r < 2180) { r -= 1828; ti.src = inp(p, 20) + (size_t)layer * 2048 * 5632; ti.dst = (bf16_t*)(wl + OFF_WGU2); ti.K = 2048; ti.N = 5632; ti.mode = 1; ti.perm = 1; ntn = 88; }
    else if (r < 2532) { r -= 2180; ti.src = inp(p, 21) + (size_t)layer * 2048 * 5632; ti.dst = (bf16_t*)(wl + OFF_WGU2); ti.K = 2048; ti.N = 5632; ti.mode = 2; ti.perm = 1; ntn = 88; }
    else               { r -= 2532; ti.src = inp(p, 22) + (size_t)layer * 5632 * 2048; ti.dst = (bf16_t*)(wl + OFF_WD2);  ti.K = 5632; ti.N = 2048; ti.mode = 0; ti.perm = 0; ntn = 32; }
    ti.k0 = (r / ntn) * 512; ti.n0 = (r % ntn) * 64;
}
__device__ __forceinline__ void conv_load(const TileInfo& ti, f32x4 (&r)[16], int tid) {
    const int lane = tid & 63, wave = tid >> 6, n = ti.n0 + (lane & 15) * 4, k = ti.k0 + wave * 64 + (lane >> 4) * 16;
#pragma unroll
    for (int i = 0; i < 16; ++i) {
        if (n < ti.N) r[i] = __builtin_nontemporal_load((const f32x4*)(ti.src + (size_t)(k + i) * ti.N + n));
        else r[i] = (f32x4){0.f, 0.f, 0.f, 0.f};
    }
}
constexpr int DEF_TILES = 996, DEF_G1A = 0, DEF_G1B = 240, DEF_G3 = 480, DEF_S1 = 612, DEF_S3 = 804;
constexpr int DEF_G2A = 996, DEF_G2B = 1076, DEF2_G2A = 1156;
constexpr int DEF1_TILES = 1236;
constexpr int DEF2_FIRST = 1828, DEF2_TILES = 996, DEF2_G1A = 1828, DEF2_G3 = 2068, DEF2_S1 = 2200, DEF2_S3 = 2392, DEF2_G1B = 2584;
__device__ __forceinline__ int conv_tile_id(int t, bool deferred) {
    if (!deferred || t < CONV_TILES_LAYER) return t;
    const int u = t - CONV_TILES_LAYER + DEF1_TILES;
    return CONV_TILES_LAYER + (u < DEF2_FIRST ? u : u + DEF2_TILES);
}

__device__ __forceinline__ void convert_tiles(const Params& p, int tid, int first, int stride, int count, bool phase0, bool deferred) {
    f32x4 r[16], rn[16];
    if (count > 0) { TileInfo t0; conv_decode(p, phase0 ? conv_tile_id(first, deferred) : first, t0); conv_load(t0, r, tid); }
    for (int i = 0; i < count; ++i) {
        const int t = first + i * stride;
        if (i + 1 < count) { TileInfo tin; conv_decode(p, phase0 ? conv_tile_id(t + stride, deferred) : t + stride, tin); conv_load(tin, rn, tid); }
        {
            TileInfo ti; conv_decode(p, phase0 ? conv_tile_id(t, deferred) : t, ti);
            const int lane = tid & 63, wave = tid >> 6, n = ti.n0 + (lane & 15) * 4, k = ti.k0 + wave * 64 + (lane >> 4) * 16;
            if (n < ti.N) {
#pragma unroll
                for (int j = 0; j < 4; ++j) {
                    u32x4 w0, w1;
                    w0.x = cvt_pk_bf16(r[0][j], r[1][j]);  w0.y = cvt_pk_bf16(r[2][j], r[3][j]);   w0.z = cvt_pk_bf16(r[4][j], r[5][j]);   w0.w = cvt_pk_bf16(r[6][j], r[7][j]);
                    w1.x = cvt_pk_bf16(r[8][j], r[9][j]);  w1.y = cvt_pk_bf16(r[10][j], r[11][j]); w1.z = cvt_pk_bf16(r[12][j], r[13][j]); w1.w = cvt_pk_bf16(r[14][j], r[15][j]);
                    const int nn = n + j;
                    int row = nn;
                    if (ti.mode == 1) row = (nn >> 7) * 256 + (nn & 127);
                    else if (ti.mode == 2) row = (nn >> 7) * 256 + 128 + (nn & 127);
                    if (ti.perm) row = (row & ~31) + pg8::perm32_inv(row & 31);
                    *(u32x4*)(ti.dst + pg8::img_off(row, k, ti.K >> 6)) = w0; *(u32x4*)(ti.dst + pg8::img_off(row, k + 8, ti.K >> 6)) = w1;
                }
            }
        }
#pragma unroll
        for (int i2 = 0; i2 < 16; ++i2) r[i2] = rn[i2];
    }
}
__device__ __forceinline__ void convert_deferred(const Params& p, int l1_first, int count) {
    int f = CONV_TILES_LAYER + l1_first; asm volatile("" : "+s"(f));
    convert_tiles(p, opaque_tid(), f, 1, count, false, true);
}
__device__ void phase_convert(const Params& p, unsigned char* lds_raw) {
    const int tid = opaque_tid();
    const bool deferred = (gridDim.x == 256);
    const int total = deferred ? 2 * CONV_TILES_LAYER - DEF1_TILES - DEF2_TILES : 2 * CONV_TILES_LAYER;
    int t = blockIdx.x; asm volatile("" : "+s"(t));
    const int count = (t < total) ? (total - t + (int)gridDim.x - 1) / (int)gridDim.x : 0;
    convert_tiles(p, tid, t, gridDim.x, count, true, deferred);
    for (int layer = 0; layer < 2; ++layer) {
        bf16_t* wz = (bf16_t*)(p.ws + (size_t)layer * SZ_LAYERW + OFF_WIN);
        for (int i = blockIdx.x * NTHREADS + tid; i < (N_IN_PAD - N_IN) * 256; i += gridDim.x * NTHREADS)
            *(u32x4*)(wz + pg8::img_off(N_IN + (i >> 8), (i & 255) * 8, 32)) = (u32x4){0u, 0u, 0u, 0u};
    }
}

template <int MODE>
__device__ __forceinline__ void norm_row(const Params& p, const f32x4 (&g)[8], int r, int lane, int nparts, float pscale) {
    float* X = (float*)(p.ws + WS_X); bf16_t* H = (bf16_t*)(p.ws + WS_H);
    const float* src = (MODE == 0) ? (r < 8192 ? inp(p, 0) + (size_t)r * 2048 : inp(p, 1) + (size_t)(r - 8192) * 2048) : X + (size_t)r * 2048;
    f32x4 v[8]; float ss = 0.f;
#pragma unroll
    for (int i = 0; i < 8; ++i) v[i] = *(const f32x4*)(src + i * 256 + lane * 4);
    if (MODE != 0 && nparts > 0 && r >= 8192) {
        const float* pp = (const float*)(p.ws + WS_ST) + (size_t)(r - 8192) * 2048 + lane * 4;
        f32x4 a[8];
#pragma unroll
        for (int i = 0; i < 8; ++i) a[i] = (f32x4){0.f, 0.f, 0.f, 0.f};
        for (int k = 0; k < nparts; ++k) {
#pragma unroll
            for (int i = 0; i < 8; ++i) a[i] += *(const f32x4*)(pp + (size_t)k * (512 * 2048) + i * 256);
        }
#pragma unroll
        for (int i = 0; i < 8; ++i) { v[i] += pscale * a[i]; *(f32x4*)(X + (size_t)r * 2048 + i * 256 + lane * 4) = v[i]; }
    }
#pragma unroll
    for (int i = 0; i < 8; ++i) ss += v[i][0] * v[i][0] + v[i][1] * v[i][1] + v[i][2] * v[i][2] + v[i][3] * v[i][3];
#pragma unroll
    for (int o = 32; o >= 1; o >>= 1) ss += __shfl_xor(ss, o);
    const float rstd = rsqrtf(ss * (1.f / 2048.f) + EPS);
#pragma unroll
    for (int i = 0; i < 8; ++i) {
        if (MODE == 0) *(f32x4*)(X + (size_t)r * 2048 + i * 256 + lane * 4) = v[i];
        const f32x4 o = v[i] * rstd * g[i];
        if (MODE < 2) { u32x2 w; w.x = cvt_pk_bf16(o[0], o[1]); w.y = cvt_pk_bf16(o[2], o[3]); *(u32x2*)(H + pg8::img_off(r, i * 256 + lane * 4, 32)) = w; }
        else *(f32x4*)(p.out + (size_t)r * 2048 + i * 256 + lane * 4) = o;
    }
}
template <int MODE>
__device__ void phase_norm(const Params& p, const float* gamma, int nparts, float pscale) {
    const int tid = opaque_tid(), lane = tid & 63, wave = tid >> 6;
    f32x4 g[8];
#pragma unroll
    for (int i = 0; i < 8; ++i) g[i] = *(const f32x4*)(gamma + i * 256 + lane * 4);
    if (wave < 2) for (int s = blockIdx.x * 2 + wave; s < 512; s += gridDim.x * 2) norm_row<MODE>(p, g, 8192 + s, lane, nparts, pscale);
    for (int r = blockIdx.x * 8 + wave; r < 8192; r += gridDim.x * 8) norm_row<MODE>(p, g, r, lane, nparts, pscale);
}

__device__ __forceinline__ u32x4 fetch_xbc8(const bf16_t* proj, const float* hist, int c, int lrow, int col) {
    if (lrow >= 0 || (c > 0 && c < NPCH)) return *(const u32x4*)(proj + (size_t)(c * 64 + lrow) * PROJ_LD + 5120 + col);
    if (c == 0) return (u32x4){0u, 0u, 0u, 0u};
    const float* h = hist + ((size_t)(c - NPCH) * 3 + (3 + lrow)) * 4096 + col;
    const f32x4 a = *(const f32x4*)h, b = *(const f32x4*)(h + 4);
    u32x4 w; w.x = cvt_pk_bf16(a[0], a[1]); w.y = cvt_pk_bf16(a[2], a[3]); w.z = cvt_pk_bf16(b[0], b[1]); w.w = cvt_pk_bf16(b[2], b[3]);
    return w;
}
__device__ __forceinline__ void dt_acum(const Params& p, int layer, int c, int h, int lane, float& dtv, float& acum, float& total) {
    const float* DT = (const float*)(p.ws + WS_DT);
    const float raw = DT[(size_t)(c * 64 + lane) * 32 + h];
    dtv = softplus_f(raw + inp(p, 14)[layer * 32 + h]);
    const float A = -expf(inp(p, 15)[layer * 32 + h]);
    float a = dtv * A;
#pragma unroll
    for (int o = 1; o < 64; o <<= 1) { const float t = __shfl_up(a, o); if (lane >= o) a += t; }
    acum = a; total = __shfl(a, 63);
}

__device__ void phase_s1(const Params& p, int layer, unsigned char* lds) {
    bf16_t* s_xwT = (bf16_t*)lds;
    bf16_t* s_BT = (bf16_t*)(lds + 36864);
    float* s_w = (float*)(lds + 55296);
    const int tid = opaque_tid(), lane = tid & 63, wave = tid >> 6, fr = lane & 15, fq = lane >> 4;
    const bf16_t* proj = (const bf16_t*)(p.ws + WS_PROJ);
    bf16_t* mix = (bf16_t*)(p.ws + WS_MIX);
    bf16_t* ST = (bf16_t*)(p.ws + WS_ST);
    float* DEC = (float*)(p.ws + WS_DEC);
    const float* hist = inp(p, 3) + (size_t)layer * 8 * 3 * 4096;
    for (int unit = blockIdx.x; unit < NCHUNK * 8; unit += gridDim.x) {
        const int c = unit >> 3, g = unit & 7, row0 = c * 64;
        const bool last_chunk = (c >= NPCH - 1);
        if (wave < 4) {
            const int h = g * 4 + wave; float dtv, acum, total;
            dt_acum(p, layer, c, h, lane, dtv, acum, total);
            s_w[wave * 64 + lane] = dtv * __expf(total - acum);
            if (lane == 0) DEC[c * 32 + h] = __expf(total);
        }
        __syncthreads();
        if (tid < 384) {
            const int rr = tid & 7, cg = tid >> 3, l0 = rr * 8;
            const int col = (cg < 32) ? g * 256 + cg * 8 : 2048 + g * 128 + (cg - 32) * 8;
            u32x4 rows[11];
#pragma unroll
            for (int i = 0; i < 11; ++i) rows[i] = fetch_xbc8(proj, hist, c, l0 - 3 + i, col);
            const float* cw = inp(p, 12) + (size_t)layer * 4 * 4096 + col; const float* cb = inp(p, 13) + (size_t)layer * 4096 + col;
            float w[4][8], b[8];
#pragma unroll
            for (int k = 0; k < 4; ++k) { const f32x4 a = *(const f32x4*)(cw + k * 4096), bb = *(const f32x4*)(cw + k * 4096 + 4);
#pragma unroll
                for (int j = 0; j < 4; ++j) { w[k][j] = a[j]; w[k][4 + j] = bb[j]; } }
            { const f32x4 a = *(const f32x4*)cb, bb = *(const f32x4*)(cb + 4);
#pragma unroll
              for (int j = 0; j < 4; ++j) { b[j] = a[j]; b[4 + j] = bb[j]; } }
            float sc[8];
#pragma unroll
            for (int i = 0; i < 8; ++i) sc[i] = (cg < 32) ? s_w[(cg >> 3) * 64 + l0 + i] : 1.f;
            bf16_t* dstT = (cg < 32) ? s_xwT + (cg * 8) * 72 + l0 : s_BT + ((cg - 32) * 8) * 72 + l0;
#pragma unroll
            for (int j = 0; j < 8; ++j) {
                float o[8];
#pragma unroll
                for (int i = 0; i < 8; ++i) {
                    float v = b[j];
#pragma unroll
                    for (int k = 0; k < 4; ++k) v += w[k][j] * bfv(rows[i + k], j);
                    o[i] = silu_f(v) * sc[i];
                }
                u32x4 pk; pk.x = cvt_pk_bf16(o[0], o[1]); pk.y = cvt_pk_bf16(o[2], o[3]); pk.z = cvt_pk_bf16(o[4], o[5]); pk.w = cvt_pk_bf16(o[6], o[7]);
                *(u32x4*)(dstT + j * 72) = pk;
            }
        } else {
            const int t2 = tid - 384, rr = t2 & 7, cgi = t2 >> 3, l0 = rr * 8, ch0 = g * 128 + cgi * 8;
            const float* scw = inp(p, 11) + (size_t)layer * 3 * 1024 + ch0;
            float w[3][8];
#pragma unroll
            for (int k = 0; k < 3; ++k) { const f32x4 a = *(const f32x4*)(scw + k * 1024), bb = *(const f32x4*)(scw + k * 1024 + 4);
#pragma unroll
                for (int j = 0; j < 4; ++j) { w[k][j] = a[j]; w[k][4 + j] = bb[j]; } }
            float um2[8], um1[8], u0[8];
#pragma unroll
            for (int i = 0; i < 10; ++i) {
                const int lrow = l0 - 2 + i;
#pragma unroll
                for (int j = 0; j < 8; ++j) { um2[j] = um1[j]; um1[j] = u0[j]; }
                if (lrow >= 0 || (c > 0 && c < NPCH)) {
                    const bf16_t* rp = proj + (size_t)(row0 + lrow) * PROJ_LD + ch0;
                    const u32x4 cv = *(const u32x4*)(rp + 1024), xv = *(const u32x4*)(rp + 2048);
#pragma unroll
                    for (int j = 0; j < 8; ++j) u0[j] = bfv(cv, j) * bfv(xv, j);
                } else if (c == 0) {
#pragma unroll
                    for (int j = 0; j < 8; ++j) u0[j] = 0.f;
                } else {
                    const float* hp = inp(p, 2) + (((size_t)layer * 8 + (c - NPCH)) * 2 + (2 + lrow)) * 1024 + ch0;
                    const f32x4 a = *(const f32x4*)hp, bb = *(const f32x4*)(hp + 4);
#pragma unroll
                    for (int j = 0; j < 4; ++j) { u0[j] = a[j]; u0[4 + j] = bb[j]; }
                }
                if (i >= 2) {
                    const int l = l0 + i - 2;
                    const u32x4 bv = *(const u32x4*)(proj + (size_t)(row0 + l) * PROJ_LD + ch0);
                    float y[8];
#pragma unroll
                    for (int j = 0; j < 8; ++j) y[j] = bfv(bv, j) * (w[0][j] * um2[j] + w[1][j] * um1[j] + w[2][j] * u0[j]);
                    u32x4 pk; pk.x = cvt_pk_bf16(y[0], y[1]); pk.y = cvt_pk_bf16(y[2], y[3]); pk.z = cvt_pk_bf16(y[4], y[5]); pk.w = cvt_pk_bf16(y[6], y[7]);
                    *(u32x4*)(mix + pg8::img_off(row0 + l, ch0, D_MIX / 64)) = pk;
                    if (last_chunk && l >= 62) {
                        float* op = (c < NPCH) ? p.out + O_SC_P + ((size_t)layer * 2 + (l - 62)) * 1024 + ch0
                                               : p.out + O_SC_S + (((size_t)layer * 8 + (c - NPCH)) * 2 + (l - 62)) * 1024 + ch0;
                        *(f32x4*)op = (f32x4){u0[0], u0[1], u0[2], u0[3]}; *(f32x4*)(op + 4) = (f32x4){u0[4], u0[5], u0[6], u0[7]};
                    }
                }
            }
        }
        __syncthreads();
        {
            const int hh = wave >> 1, half = wave & 1, h = g * 4 + hh;
            f32x4 acc[4][4];
#pragma unroll
            for (int a = 0; a < 4; ++a)
#pragma unroll
                for (int b = 0; b < 4; ++b) acc[a][b] = (f32x4){0.f, 0.f, 0.f, 0.f};
#pragma unroll
            for (int ks = 0; ks < 2; ++ks) {
                bf16x8 af[4], bfr[4];
#pragma unroll
                for (int a = 0; a < 4; ++a) af[a] = *(const bf16x8*)(s_BT + (half * 64 + a * 16 + fr) * 72 + ks * 32 + fq * 8);
#pragma unroll
                for (int b = 0; b < 4; ++b) bfr[b] = *(const bf16x8*)(s_xwT + (hh * 64 + b * 16 + fr) * 72 + ks * 32 + fq * 8);
#pragma unroll
                for (int a = 0; a < 4; ++a)
#pragma unroll
                    for (int b = 0; b < 4; ++b) acc[a][b] = __builtin_amdgcn_mfma_f32_16x16x32_bf16(af[a], bfr[b], acc[a][b], 0, 0, 0);
            }
            bf16_t* stp = ST + ((size_t)(c * 32 + h) * 64) * 128;
#pragma unroll
            for (int a = 0; a < 4; ++a)
#pragma unroll
                for (int b = 0; b < 4; ++b) {
                    u32x2 w; w.x = cvt_pk_bf16(acc[a][b][0], acc[a][b][1]); w.y = cvt_pk_bf16(acc[a][b][2], acc[a][b][3]);
                    *(u32x2*)(stp + (size_t)(b * 16 + fr) * 128 + half * 64 + a * 16 + fq * 4) = w;
                }
        }
        __syncthreads();
    }
}

__device__ void phase_s2(const Params& p, int layer) {
    unsigned* ST32 = (unsigned*)(p.ws + WS_ST);
    const float* DEC = (const float*)(p.ws + WS_DEC);
    constexpr int NP = 32 * 64 * 128 / 2;
    const int gtid = blockIdx.x * NTHREADS + opaque_tid(), nth = gridDim.x * NTHREADS;
    for (int idx = gtid; idx < NP; idx += nth) {
        const int h = idx >> 12;
        float s0 = 0.f, s1 = 0.f;
        for (int c0 = 0; c0 < NPCH; c0 += 16) {
            unsigned v[16]; float d[16];
#pragma unroll
            for (int j = 0; j < 16; ++j) { v[j] = ST32[(size_t)(c0 + j) * NP + idx]; d[j] = DEC[(c0 + j) * 32 + h]; }
#pragma unroll
            for (int j = 0; j < 16; ++j) {
                ST32[(size_t)(c0 + j) * NP + idx] = cvt_pk_bf16(s0, s1);
                s0 = s0 * d[j] + bf_lo(v[j]); s1 = s1 * d[j] + bf_hi(v[j]);
            }
        }
        *(f32x2*)(p.out + O_SSM_P + (size_t)layer * 262144 + 2 * (size_t)idx) = (f32x2){s0, s1};
    }
    for (int it = gtid; it < 8 * NP; it += nth) {
        const int b = it / NP, idx = it % NP, h = idx >> 12;
        const f32x2 s = *(const f32x2*)(inp(p, 4) + ((size_t)layer * 8 + b) * 262144 + 2 * (size_t)idx);
        const unsigned v = ST32[(size_t)(NPCH + b) * NP + idx];
        const float d = DEC[(NPCH + b) * 32 + h];
        ST32[(size_t)(NPCH + b) * NP + idx] = cvt_pk_bf16(s[0], s[1]);
        *(f32x2*)(p.out + O_SSM_S + ((size_t)layer * 8 + b) * 262144 + 2 * (size_t)idx) = (f32x2){s[0] * d + bf_lo(v), s[1] * d + bf_hi(v)};
    }
}

__device__ void phase_s3(const Params& p, int layer, unsigned char* lds) {
    bf16_t* s_xsT = (bf16_t*)lds;
    bf16_t* s_B = (bf16_t*)(lds + 36864);
    bf16_t* s_C = (bf16_t*)(lds + 36864 + 17408);
    bf16_t* s_M = (bf16_t*)(lds + 71680);
    float* s_dt = (float*)(lds + 108544);
    float* s_acum = s_dt + 256;
    float* s_ssq = s_acum + 256;
    const int tid = opaque_tid(), lane = tid & 63, wave = tid >> 6, fr = lane & 15, fq = lane >> 4;
    const bf16_t* proj = (const bf16_t*)(p.ws + WS_PROJ);
    bf16_t* mix = (bf16_t*)(p.ws + WS_MIX);
    const bf16_t* ST = (const bf16_t*)(p.ws + WS_ST);
    const float* hist = inp(p, 3) + (size_t)layer * 8 * 3 * 4096;
    for (int unit = blockIdx.x; unit < NCHUNK * 8; unit += gridDim.x) {
        const int c = unit >> 3, g = unit & 7, row0 = c * 64;
        const bool last_chunk = (c >= NPCH - 1);
        if (wave < 4) {
            const int h = g * 4 + wave; float dtv, acum, total;
            dt_acum(p, layer, c, h, lane, dtv, acum, total);
            s_dt[wave * 64 + lane] = dtv; s_acum[wave * 64 + lane] = acum;
        }
        {
            const int rr = tid & 7, cg = tid >> 3, l0 = rr * 8;
            const int col = (cg < 32) ? g * 256 + cg * 8 : (cg < 48 ? 2048 + g * 128 + (cg - 32) * 8 : 3072 + g * 128 + (cg - 48) * 8);
            u32x4 rows[11];
#pragma unroll
            for (int i = 0; i < 11; ++i) rows[i] = fetch_xbc8(proj, hist, c, l0 - 3 + i, col);
            const float* cw = inp(p, 12) + (size_t)layer * 4 * 4096 + col; const float* cb = inp(p, 13) + (size_t)layer * 4096 + col;
            float w[4][8], b[8];
#pragma unroll
            for (int k = 0; k < 4; ++k) { const f32x4 a = *(const f32x4*)(cw + k * 4096), bb = *(const f32x4*)(cw + k * 4096 + 4);
#pragma unroll
                for (int j = 0; j < 4; ++j) { w[k][j] = a[j]; w[k][4 + j] = bb[j]; } }
            { const f32x4 a = *(const f32x4*)cb, bb = *(const f32x4*)(cb + 4);
#pragma unroll
              for (int j = 0; j < 4; ++j) { b[j] = a[j]; b[4 + j] = bb[j]; } }
            if (last_chunk && rr == 7) {
#pragma unroll
                for (int i = 0; i < 3; ++i) {
                    float* op = (c < NPCH) ? p.out + O_CONV_P + ((size_t)layer * 3 + i) * 4096 + col
                                           : p.out + O_CONV_S + (((size_t)layer * 8 + (c - NPCH)) * 3 + i) * 4096 + col;
                    const u32x4 rv = rows[8 + i];
                    *(f32x4*)op = (f32x4){bf_lo(rv.x), bf_hi(rv.x), bf_lo(rv.y), bf_hi(rv.y)}; *(f32x4*)(op + 4) = (f32x4){bf_lo(rv.z), bf_hi(rv.z), bf_lo(rv.w), bf_hi(rv.w)};
                }
            }
            if (cg < 32) {
#pragma unroll
                for (int j = 0; j < 8; ++j) {
                    float o[8];
#pragma unroll
                    for (int i = 0; i < 8; ++i) {
                        float v = b[j];
#pragma unroll
                        for (int k = 0; k < 4; ++k) v += w[k][j] * bfv(rows[i + k], j);
                        o[i] = silu_f(v);
                    }
                    u32x4 pk; pk.x = cvt_pk_bf16(o[0], o[1]); pk.y = cvt_pk_bf16(o[2], o[3]); pk.z = cvt_pk_bf16(o[4], o[5]); pk.w = cvt_pk_bf16(o[6], o[7]);
                    *(u32x4*)(s_xsT + (cg * 8 + j) * 72 + l0) = pk;
                }
            } else {
                bf16_t* dst = (cg < 48) ? s_B + (cg - 32) * 8 : s_C + (cg - 48) * 8;
#pragma unroll
                for (int i = 0; i < 8; ++i) {
                    float o[8];
#pragma unroll
                    for (int j = 0; j < 8; ++j) {
                        float v = b[j];
#pragma unroll
                        for (int k = 0; k < 4; ++k) v += w[k][j] * bfv(rows[i + k], j);
                        o[j] = silu_f(v);
                    }
                    u32x4 pk; pk.x = cvt_pk_bf16(o[0], o[1]); pk.y = cvt_pk_bf16(o[2], o[3]); pk.z = cvt_pk_bf16(o[4], o[5]); pk.w = cvt_pk_bf16(o[6], o[7]);
                    *(u32x4*)(dst + (l0 + i) * 136) = pk;
                }
            }
        }
        __syncthreads();
        const int hh_y = wave >> 1, half_y = wave & 1, h_y = g * 4 + hh_y;
        u32x2 zv[2][4];
#pragma unroll
        for (int lti = 0; lti < 2; ++lti)
#pragma unroll
            for (int pt = 0; pt < 4; ++pt) zv[lti][pt] = *(const u32x2*)(proj + (size_t)(row0 + (2 * half_y + lti) * 16 + fr) * PROJ_LD + 3072 + h_y * 64 + pt * 16 + fq * 4);
        bf16x8 aPall[4][4];
        {
            const bf16_t* prev = ST + ((size_t)(c * 32 + h_y) * 64) * 128;
#pragma unroll
            for (int ks = 0; ks < 4; ++ks)
#pragma unroll
                for (int pt = 0; pt < 4; ++pt) aPall[ks][pt] = *(const bf16x8*)(prev + (size_t)(pt * 16 + fr) * 128 + ks * 32 + fq * 8);
        }
        {
            const int lt = wave >> 1;
#pragma unroll
            for (int sti = 0; sti < 2; ++sti) {
                const int st = (wave & 1) * 2 + sti;
                f32x4 acc = (f32x4){0.f, 0.f, 0.f, 0.f};
                if (st <= lt) {
#pragma unroll
                    for (int ks = 0; ks < 4; ++ks) {
                        const bf16x8 a = *(const bf16x8*)(s_C + (lt * 16 + fr) * 136 + ks * 32 + fq * 8);
                        const bf16x8 b = *(const bf16x8*)(s_B + (st * 16 + fr) * 136 + ks * 32 + fq * 8);
                        acc = __builtin_amdgcn_mfma_f32_16x16x32_bf16(a, b, acc, 0, 0, 0);
                    }
                }
                const int s = st * 16 + fr;
#pragma unroll
                for (int hh = 0; hh < 4; ++hh) {
                    const float as = s_acum[hh * 64 + s], ds = s_dt[hh * 64 + s], Dh = inp(p, 16)[layer * 32 + g * 4 + hh];
#pragma unroll
                    for (int r = 0; r < 4; ++r) {
                        const int l = lt * 16 + fq * 4 + r;
                        float v = 0.f;
                        if (s <= l) v = acc[r] * __expf(s_acum[hh * 64 + l] - as) * ds;
                        if (s == l) v += Dh;
                        s_M[(hh * 64 + l) * 72 + s] = (bf16_t)(cvt_pk_bf16(v, 0.f) & 0xffffu);
                    }
                }
            }
        }
        __syncthreads();
        {
            const int hh = wave >> 1, half = wave & 1, h = g * 4 + hh;
            f32x4 acc1[2][4], acc2[2][4];
#pragma unroll
            for (int a = 0; a < 2; ++a)
#pragma unroll
                for (int b = 0; b < 4; ++b) { acc1[a][b] = (f32x4){0.f, 0.f, 0.f, 0.f}; acc2[a][b] = (f32x4){0.f, 0.f, 0.f, 0.f}; }
#pragma unroll
            for (int ks = 0; ks < 4; ++ks) {
                bf16x8 bC[2];
#pragma unroll
                for (int lti = 0; lti < 2; ++lti) bC[lti] = *(const bf16x8*)(s_C + ((2 * half + lti) * 16 + fr) * 136 + ks * 32 + fq * 8);
#pragma unroll
                for (int lti = 0; lti < 2; ++lti)
#pragma unroll
                    for (int pt = 0; pt < 4; ++pt) acc2[lti][pt] = __builtin_amdgcn_mfma_f32_16x16x32_bf16(aPall[ks][pt], bC[lti], acc2[lti][pt], 0, 0, 0);
            }
#pragma unroll
            for (int ks = 0; ks < 2; ++ks) {
                bf16x8 bM[2], aX[4];
#pragma unroll
                for (int lti = 0; lti < 2; ++lti) bM[lti] = *(const bf16x8*)(s_M + (hh * 64 + (2 * half + lti) * 16 + fr) * 72 + ks * 32 + fq * 8);
#pragma unroll
                for (int pt = 0; pt < 4; ++pt) aX[pt] = *(const bf16x8*)(s_xsT + (hh * 64 + pt * 16 + fr) * 72 + ks * 32 + fq * 8);
#pragma unroll
                for (int lti = 0; lti < 2; ++lti)
#pragma unroll
                    for (int pt = 0; pt < 4; ++pt) acc1[lti][pt] = __builtin_amdgcn_mfma_f32_16x16x32_bf16(aX[pt], bM[lti], acc1[lti][pt], 0, 0, 0);
            }
#pragma unroll
            for (int lti = 0; lti < 2; ++lti) {
                const int l = (2 * half + lti) * 16 + fr;
                const float e = __expf(s_acum[hh * 64 + l]);
                float ss = 0.f;
#pragma unroll
                for (int pt = 0; pt < 4; ++pt) {
                    const float z0 = bf_lo(zv[lti][pt].x), z1 = bf_hi(zv[lti][pt].x), z2 = bf_lo(zv[lti][pt].y), z3 = bf_hi(zv[lti][pt].y);
                    f32x4 u = acc1[lti][pt] + e * acc2[lti][pt];
                    u[0] *= silu_f(z0); u[1] *= silu_f(z1); u[2] *= silu_f(z2); u[3] *= silu_f(z3);
                    acc1[lti][pt] = u;
                    ss += u[0] * u[0] + u[1] * u[1] + u[2] * u[2] + u[3] * u[3];
                }
                ss += __shfl_xor(ss, 16); ss += __shfl_xor(ss, 32);
                if (fq == 0) s_ssq[hh * 64 + l] = ss;
            }
            __syncthreads();
            const float* nw = inp(p, 17) + (size_t)layer * 2048 + h * 64;
#pragma unroll
            for (int lti = 0; lti < 2; ++lti) {
                const int l = (2 * half + lti) * 16 + fr;
                const float scale = rsqrtf(((s_ssq[l] + s_ssq[64 + l]) + (s_ssq[128 + l] + s_ssq[192 + l])) * (1.f / 256.f) + EPS);
#pragma unroll
                for (int pt = 0; pt < 4; ++pt) {
                    const f32x4 w4 = *(const f32x4*)(nw + pt * 16 + fq * 4);
                    const f32x4 o = acc1[lti][pt] * scale * w4;
                    u32x2 w; w.x = cvt_pk_bf16(o[0], o[1]); w.y = cvt_pk_bf16(o[2], o[3]);
                    *(u32x2*)(mix + pg8::img_off(row0 + l, 1024 + h * 64 + pt * 16 + fq * 4, D_MIX / 64)) = w;
                }
            }
        }
        __syncthreads();
    }
}

#define XB_TMO      128
#define XB_XCNT(j)  (256  + 64 * (j))
#define XB_XSUB(j)  (1280 + 64 * (j))
#define XB_XGEN(j)  (2304 + 64 * (j))
#define XB_TOP      3328
#define XB_TOPGEN   3392
#define XCD_BAR_WORDS 3456
#define XB_SPIN_CAP (1u << 18)

__device__ __forceinline__ unsigned xb_ld(unsigned* p)              { return __hip_atomic_load(p, __ATOMIC_RELAXED, __HIP_MEMORY_SCOPE_AGENT); }
__device__ __forceinline__ unsigned xb_add(unsigned* p, unsigned v) { return __hip_atomic_fetch_add(p, v, __ATOMIC_RELAXED, __HIP_MEMORY_SCOPE_AGENT); }
__device__ __forceinline__ unsigned xb_xcc_id() { return (unsigned)__builtin_amdgcn_s_getreg((3 << 11) | 20) & 0xFu; }
#define XB_SPIN(cond, bar) do { unsigned _sp = 0; while (cond) { __builtin_amdgcn_s_sleep(1); \
    if ((++_sp & 255u) == 0u) { if (xb_ld(&(bar)[XB_TMO])) break; if (_sp > XB_SPIN_CAP) { atomicAdd(&(bar)[XB_TMO], 1u); break; } } } } while (0)

struct XcdBarrier {
    unsigned* bar; unsigned x;
    volatile LAS unsigned* st;
};

__device__ __forceinline__ XcdBarrier xcd_barrier_post(unsigned* bar, volatile LAS unsigned* st) {
    XcdBarrier b; b.bar = bar; b.x = xb_xcc_id(); b.st = st;
    if (threadIdx.x == 0) (void)xb_add(&bar[XB_XCNT(b.x)], 1u);
    return b;
}
__device__ __forceinline__ void xcd_barrier_complete(unsigned* bar, unsigned x, unsigned& nloc, unsigned& nx) {
    const unsigned G = gridDim.x * gridDim.y * gridDim.z;
    unsigned sum, cnt, mine, sp = 0u;
    for (;;) {
        sum = 0u; cnt = 0u; mine = 0u;
#pragma unroll
        for (unsigned j = 0; j < 16; ++j) { const unsigned c = xb_ld(&bar[XB_XCNT(j)]); sum += c; cnt += (c > 0u) ? 1u : 0u; mine = (j == x) ? c : mine; }
        if (sum == G) break;
        __builtin_amdgcn_s_sleep(1);
        if ((++sp & 255u) == 0u) { if (xb_ld(&bar[XB_TMO])) break; if (sp > XB_SPIN_CAP) { atomicAdd(&bar[XB_TMO], 1u); break; } }
    }
    nloc = mine > 0u ? mine : 1u; nx = cnt > 0u ? cnt : 1u;
}

__device__ __forceinline__ void xcd_barrier(const XcdBarrier& b) {
    asm volatile("s_waitcnt vmcnt(0)" ::: "memory");
    __syncthreads();
    if (threadIdx.x == 0) {
        unsigned* bar = b.bar;
        __builtin_amdgcn_s_waitcnt(0);
        unsigned nloc = b.st[0], nx = b.st[1];
        if (nloc == 0u) { xcd_barrier_complete(bar, b.x, nloc, nx); b.st[0] = nloc; b.st[1] = nx; }
        const unsigned old = xb_add(&bar[XB_XSUB(b.x)], 1u);
        const unsigned gen = old / nloc;
        if (old + 1u == (gen + 1u) * nloc) {
            __builtin_amdgcn_fence(__ATOMIC_RELEASE, "agent");
            asm volatile("s_waitcnt vmcnt(0)" ::: "memory");
            const unsigned og = xb_add(&bar[XB_TOP], 1u);
            const unsigned tg = og / nx;
            if (og + 1u == (tg + 1u) * nx) xb_add(&bar[XB_TOPGEN], 1u);
            else XB_SPIN(xb_ld(&bar[XB_TOPGEN]) == tg, bar);
            __builtin_amdgcn_fence(__ATOMIC_ACQUIRE, "agent");
            xb_add(&bar[XB_XGEN(b.x)], 1u);
            asm volatile("s_waitcnt vmcnt(0)" ::: "memory");
        } else {
            XB_SPIN(xb_ld(&bar[XB_XGEN(b.x)]) == gen, bar);
            __builtin_amdgcn_fence(__ATOMIC_ACQUIRE, "agent");
            asm volatile("s_waitcnt vmcnt(0)" ::: "memory");
        }
    }
    __syncthreads();
}

#ifndef PROG_LIST
#define PROG_LIST 0,1,2,3,4,5,6,7,8,9,10,11,12,13,14,15,16,17,18,19,20,21,22,23,24
#endif
__constant__ int PROG[] = {PROG_LIST};

__global__ void __launch_bounds__(NTHREADS, 2) fwd_kernel(Params p) {
    extern __shared__ __attribute__((aligned(16))) unsigned char lds_raw[];
    LAS unsigned char* lds = (LAS unsigned char*)lds_raw;
    float* X = (float*)(p.ws + WS_X); bf16_t* H = (bf16_t*)(p.ws + WS_H); bf16_t* ACT = (bf16_t*)(p.ws + WS_PROJ); bf16_t* PROJ = (bf16_t*)(p.ws + WS_PROJ);
    bf16_t* MIX = (bf16_t*)(p.ws + WS_MIX); float* DT = (float*)(p.ws + WS_DT);
    float* PART = (float*)(p.ws + WS_ST);
    const int G = gridDim.x, cblk = blockIdx.x;
    { volatile LAS unsigned* stw = (volatile LAS unsigned*)(lds + 131072); if (threadIdx.x < 4) stw[threadIdx.x] = 0u; }
    __syncthreads();
    const XcdBarrier xbar = xcd_barrier_post((unsigned*)(p.ws + WS_CTL), (volatile LAS unsigned*)(lds + 131072));
    for (int pi = p.ph_lo; pi < p.ph_hi; ++pi) {
        const int ph = PROG[pi];
        if (ph == 0) {
            phase_convert(p, lds_raw);
            phase_norm<0>(p, inp(p, 5), 0, 0.f);
        } else {
            const int layer = (ph - 1) / 12, sub = (ph - 1) % 12;
            unsigned char* wl = p.ws + (size_t)layer * SZ_LAYERW;
            if (sub == 0 || sub == 9) {
                pg8::Gemm g{H, (const bf16_t*)(wl + (sub == 0 ? OFF_WGU1 : OFF_WGU2)), M_ROWS, 11264, H_LD, 2048};
                typedef pg8::SplitOrder<M_ROWS, 11264, 1, 2048> SO; SO S; S.init(G, cblk);
                pg8::EpiSwiglu E{ACT};
                pg8::gemm_phase<pg8::EpiSwiglu, SO, H_LD>(lds, g, S, E);
                if (G == 256 && cblk >= 216) convert_deferred(p, (layer == 0 ? (sub == 0 ? DEF_G1A : DEF_G1B) : (sub == 0 ? DEF2_G1A : DEF2_G1B)) + (cblk - 216) * 6, 6);
            } else if (sub == 1 || sub == 10) {
                pg8::Gemm g{ACT, (const bf16_t*)(wl + (sub == 1 ? OFF_WD1 : OFF_WD2)), M_ROWS, 2048, ACT_LD, D_FF};
                typedef pg8::MixedOrder<D_FF, 11> SO; SO S; S.init(G, cblk);
                pg8::EpiAtomic E{X, PART, 0.5f};
                pg8::gemm_phase<pg8::EpiAtomic, SO, ACT_LD>(lds, g, S, E);
                if (G == 256 && cblk >= 176 && !(layer == 1 && sub == 10)) convert_deferred(p, (layer == 0 ? (sub == 1 ? DEF_G2A : DEF_G2B) : DEF2_G2A) + (cblk - 176), 1);
            } else if (sub == 7) {
                pg8::Gemm g{MIX, (const bf16_t*)(wl + OFF_WOUT), M_ROWS, 2048, MIX_LD, D_MIX};
                typedef pg8::MixedOrder<D_MIX, 12> SO; SO S; S.init(G, cblk);
                pg8::EpiAtomic E{X, PART, 1.0f};
                pg8::gemm_phase<pg8::EpiAtomic, SO, MIX_LD>(lds, g, S, E);
            } else if (sub == 2 || sub == 8) {
                if (sub == 2) phase_norm<1>(p, inp(p, 9) + (size_t)layer * 2048, 11, 0.5f);
                else phase_norm<1>(p, inp(p, 19) + (size_t)layer * 2048, 12, 1.0f);
            } else if (sub == 3) {
                pg8::Gemm g{H, (const bf16_t*)(wl + OFF_WIN), M_ROWS, N_IN_PAD, H_LD, 2048};
                typedef pg8::SplitOrder<M_ROWS, N_IN_PAD, 1, 2048> SO; SO S; S.init(G, cblk);
                pg8::EpiProj E{PROJ, DT};
                pg8::gemm_phase<pg8::EpiProj, SO, H_LD>(lds, g, S, E);
                if (G == 256 && cblk >= 234) convert_deferred(p, (layer == 0 ? DEF_G3 : DEF2_G3) + (cblk - 234) * 6, 6);
            } else if (sub == 4) {
                phase_s1(p, layer, lds_raw);
                if (G == 256 && cblk >= 64) convert_deferred(p, (layer == 0 ? DEF_S1 : DEF2_S1) + (cblk - 64), 1);
            } else if (sub == 5) {
                phase_s2(p, layer);
            } else if (sub == 6) {
                phase_s3(p, layer, lds_raw);
                if (G == 256 && cblk >= 64) convert_deferred(p, (layer == 0 ? DEF_S3 : DEF2_S3) + (cblk - 64), 1);
            } else {
                if (layer == 0) phase_norm<1>(p, inp(p, 5) + 2048, 11, 0.5f);
                else phase_norm<2>(p, inp(p, 23), 11, 0.5f);
            }
        }
        if (pi + 1 < p.ph_hi) {
            if (p.ph_hi > 4096) cg::this_grid().sync();
            xcd_barrier(xbar);
        }
    }
}

#ifndef PROG_LIST
#error
#endif
static const int prog_host[] = {PROG_LIST};
#define NPROG_HOST ((int)(sizeof(prog_host) / sizeof(int)))
extern "C" void kernel_launch(void* const* d_in, const int* in_sizes, int n_in, void* d_out, int out_size, void* d_ws, size_t ws_size, hipStream_t stream) {
    static int grid = 0;
    if (grid == 0) {
        int dev = 0, cus = 0, per_cu = 0;
        hipGetDevice(&dev);
        hipDeviceGetAttribute(&cus, hipDeviceAttributeMultiprocessorCount, dev);
        if (hipFuncSetAttribute((const void*)fwd_kernel, hipFuncAttributeMaxDynamicSharedMemorySize, LDS_BYTES) != hipSuccess) fprintf(stderr, "kernel_launch: hipFuncSetAttribute failed\n");
        if (hipOccupancyMaxActiveBlocksPerMultiprocessor(&per_cu, (const void*)fwd_kernel, NTHREADS, LDS_BYTES) != hipSuccess || per_cu < 1) { fprintf(stderr, "kernel_launch: occupancy query says %d\n", per_cu); per_cu = 1; }
        (void)hipGetLastError();
        if (per_cu > 1) per_cu = 1;
        grid = cus * per_cu;
        if (ws_size < WS_END) fprintf(stderr, "kernel_launch: workspace too small: %zu < %zu\n", ws_size, (size_t)WS_END);
    }
    Params p{};
    for (int i = 0; i < 24; ++i) p.in[i] = (const float*)d_in[i];
    p.out = (float*)d_out; p.ws = (unsigned char*)d_ws;
#if ONE_LAUNCH
    hipMemsetAsync((unsigned char*)d_ws + WS_CTL, 0, 16384, stream);
    p.ph_lo = 0; p.ph_hi = NPROG_HOST;
    void* args[] = {&p};
    hipError_t e = hipLaunchCooperativeKernel((const void*)fwd_kernel, dim3(grid), dim3(NTHREADS), args, LDS_BYTES, stream);
    if (e != hipSuccess) fprintf(stderr, "cooperative launch failed: %s (grid %d)\n", hipGetErrorString(e), grid);
#else
#ifndef PH_LIST
#define PH_LIST 0,1,2,3,4,5,6,7,8,9,10,11,12,13,14,15,16,17,18,19,20,21,22,23,24
#endif
    const int phl[] = {PH_LIST};
    for (int ph : phl) {
        p.ph_lo = ph; p.ph_hi = ph + 1;
        hipLaunchKernelGGL(fwd_kernel, dim3(grid), dim3(NTHREADS), LDS_BYTES, stream, p);
    }
#endif
}
```
